# Optimizing an MI355X kernel written in HIP

```python
import math
import jax, jax.numpy as jnp
from jax import lax
import numpy as np

D_MODEL = 1024
BATCH = 8
SEQ = 4096
DEPTH = 4

CHUNK = 64
Q_BLOCK = 128
N_EVEN = (DEPTH + 1) // 2
N_ODD = DEPTH // 2
DIFF_HEADS = 4
DIFF_HEAD_DIM = 64
DIFF_V_DIM = 2 * DIFF_HEAD_DIM
DIFF_WIDTH = DIFF_HEADS * DIFF_V_DIM
LRU_WIDTH = 512
LRU_BLOCKS = 8
LRU_BLOCK_DIM = LRU_WIDTH // LRU_BLOCKS
LRU_C = 8.0
CONV_WIDTH = 4
AB_IN = 3 * DIFF_WIDTH + 2 * LRU_WIDTH
AB_OUT = DIFF_WIDTH + LRU_WIDTH
SGU_WIDTH = D_MODEL
SGU_GROUPS = 8
SGU_GROUP_DIM = SGU_WIDTH // SGU_GROUPS
SGU_BLOCK = 128
D_FF = 4 * D_MODEL
EPS = 1e-6

kernel_name = 'hybrid_diffattn_rglru_gmlp_trunk'


def rms_norm(x, g):
    xf = x.astype(jnp.float32)
    y = xf * lax.rsqrt(jnp.mean(xf * xf, axis=-1, keepdims=True) + EPS)
    return (y * g.astype(jnp.float32)).astype(x.dtype)


def layer_norm(x, g, b):
    xf = x.astype(jnp.float32)
    mu = jnp.mean(xf, axis=-1, keepdims=True)
    var = jnp.mean(jnp.square(xf - mu), axis=-1, keepdims=True)
    y = (xf - mu) * lax.rsqrt(var + EPS)
    return (y * g.astype(jnp.float32) + b.astype(jnp.float32)).astype(x.dtype)


def diff_attention(q, k, v, lam, lam_init, subln_g):
    b, s, _ = q.shape
    nb = s // Q_BLOCK
    qb = q.reshape(b, nb, Q_BLOCK, DIFF_HEADS, 2, DIFF_HEAD_DIM).swapaxes(0, 1)
    k = k.reshape(b, s, DIFF_HEADS, 2, DIFF_HEAD_DIM)
    v = v.reshape(b, s, DIFF_HEADS, DIFF_V_DIM)
    scale = DIFF_HEAD_DIM ** -0.5
    k_chunk = jnp.arange(s) // CHUNK

    def block(args):
        q_blk, i = args
        scores = jnp.einsum('bqhmd,bkhmd->bhmqk', q_blk, k).astype(jnp.float32) * scale
        q_chunk = (i * Q_BLOCK + jnp.arange(Q_BLOCK)) // CHUNK
        mask = k_chunk[None, :] <= q_chunk[:, None]
        probs = jax.nn.softmax(jnp.where(mask, scores, -jnp.inf), axis=-1)
        w = probs[:, :, 0] - lam * probs[:, :, 1]
        return jnp.einsum('bhqk,bkhv->bqhv', w.astype(v.dtype), v)

    out = lax.map(block, (qb, jnp.arange(nb)))
    out = out.swapaxes(0, 1).reshape(b, s, DIFF_HEADS, DIFF_V_DIM)
    out = rms_norm(out, subln_g) * (1.0 - lam_init)
    return out.reshape(b, s, DIFF_WIDTH)


def rg_lru_branch(xb, gate, conv_w, conv_b, wa, ba, wx, bx, lam):
    c = xb.shape[-1]
    xc = lax.conv_general_dilated(
        xb, conv_w[:, None, :].astype(xb.dtype), window_strides=(1,),
        padding=[(CONV_WIDTH - 1, 0)], dimension_numbers=('NWC', 'WIO', 'NWC'),
        feature_group_count=c) + conv_b
    b, s, _ = xc.shape
    xh = xc.reshape(b, s, LRU_BLOCKS, LRU_BLOCK_DIM)
    r = jax.nn.sigmoid(jnp.einsum('bshi,hij->bshj', xh, wa).reshape(b, s, c) + ba)
    i = jax.nn.sigmoid(jnp.einsum('bshi,hij->bshj', xh, wx).reshape(b, s, c) + bx)
    log_a = -LRU_C * r.astype(jnp.float32) * jax.nn.softplus(-lam.astype(jnp.float32))
    a = jnp.exp(log_a)
    bt = jnp.sqrt(-jnp.expm1(2.0 * log_a)) * (i * xc).astype(jnp.float32)

    def combine(left, right):
        a1, b1 = left
        a2, b2 = right
        return a1 * a2, a2 * b1 + b2

    _, h = lax.associative_scan(combine, (a, bt), axis=1)
    return jax.nn.gelu(gate) * h.astype(xb.dtype)


def spatial_gating(z, ln_g, ln_b, w_s, b_s):
    u, v = jnp.split(z, 2, axis=-1)
    v = layer_norm(v, ln_g, ln_b)
    b, s, _ = v.shape
    vb = v.reshape(b, s // SGU_BLOCK, SGU_BLOCK, SGU_GROUPS, SGU_GROUP_DIM)
    pos_chunk = jnp.arange(SGU_BLOCK) // CHUNK
    mask = pos_chunk[None, :] <= pos_chunk[:, None]
    w = jnp.where(mask[None], w_s, 0)
    mixed = jnp.einsum('gpq,bnqgc->bnpgc', w, vb) + b_s.T[None, None, :, :, None]
    return u * mixed.reshape(b, s, SGU_WIDTH)


def setup_inputs(seed: int = 0) -> dict:
    key = jax.random.key(seed)
    ks = iter(jax.random.split(key, 40))

    def nrm(shape, scale):
        return jax.random.normal(next(ks), shape, jnp.float32) * scale

    x = nrm((BATCH, SEQ, D_MODEL), 1.0)
    norm_mix = 1.0 + nrm((DEPTH, D_MODEL), 0.02)
    norm_ffn = 1.0 + nrm((DEPTH, D_MODEL), 0.02)
    norm_final = 1.0 + nrm((D_MODEL,), 0.02)
    ab_w_in = nrm((N_EVEN, D_MODEL, AB_IN), D_MODEL ** -0.5)
    diff_lq1 = nrm((N_EVEN, DIFF_HEAD_DIM), 0.1)
    diff_lk1 = nrm((N_EVEN, DIFF_HEAD_DIM), 0.1)
    diff_lq2 = nrm((N_EVEN, DIFF_HEAD_DIM), 0.1)
    diff_lk2 = nrm((N_EVEN, DIFF_HEAD_DIM), 0.1)
    diff_subln = 1.0 + nrm((N_EVEN, DIFF_V_DIM), 0.02)
    lru_conv_w = nrm((N_EVEN, CONV_WIDTH, LRU_WIDTH), CONV_WIDTH ** -0.5)
    lru_conv_b = nrm((N_EVEN, LRU_WIDTH), 0.01)
    lru_wa = nrm((N_EVEN, LRU_BLOCKS, LRU_BLOCK_DIM, LRU_BLOCK_DIM), LRU_BLOCK_DIM ** -0.5)
    lru_ba = nrm((N_EVEN, LRU_WIDTH), 0.01)
    lru_wx = nrm((N_EVEN, LRU_BLOCKS, LRU_BLOCK_DIM, LRU_BLOCK_DIM), LRU_BLOCK_DIM ** -0.5)
    lru_bx = nrm((N_EVEN, LRU_WIDTH), 0.01)
    a0 = jax.random.uniform(next(ks), (N_EVEN, LRU_WIDTH), jnp.float32, 0.9, 0.999)
    s0 = a0 ** (1.0 / LRU_C)
    lru_lambda = jnp.log(s0) - jnp.log1p(-s0)
    ab_w_out = nrm((N_EVEN, AB_OUT, D_MODEL), AB_OUT ** -0.5)
    c_w_in = nrm((N_ODD, D_MODEL, 2 * SGU_WIDTH), D_MODEL ** -0.5)
    c_ln_g = 1.0 + nrm((N_ODD, SGU_WIDTH), 0.02)
    c_ln_b = nrm((N_ODD, SGU_WIDTH), 0.01)
    c_w_s = nrm((N_ODD, SGU_GROUPS, SGU_BLOCK, SGU_BLOCK), SGU_BLOCK ** -0.5)
    c_b_s = 1.0 + nrm((N_ODD, SGU_GROUPS, SGU_BLOCK), 0.01)
    c_w_out = nrm((N_ODD, SGU_WIDTH, D_MODEL), SGU_WIDTH ** -0.5)
    ffn_w1 = nrm((DEPTH, D_MODEL, D_FF), D_MODEL ** -0.5)
    ffn_w2 = nrm((DEPTH, D_FF, D_MODEL), D_FF ** -0.5)
    return {'x': x, 'norm_mix': norm_mix, 'norm_ffn': norm_ffn, 'norm_final': norm_final,
            'ab_w_in': ab_w_in, 'diff_lq1': diff_lq1, 'diff_lk1': diff_lk1,
            'diff_lq2': diff_lq2, 'diff_lk2': diff_lk2, 'diff_subln': diff_subln,
            'lru_conv_w': lru_conv_w, 'lru_conv_b': lru_conv_b, 'lru_wa': lru_wa,
            'lru_ba': lru_ba, 'lru_wx': lru_wx, 'lru_bx': lru_bx, 'lru_lambda': lru_lambda,
            'ab_w_out': ab_w_out, 'c_w_in': c_w_in, 'c_ln_g': c_ln_g, 'c_ln_b': c_ln_b,
            'c_w_s': c_w_s, 'c_b_s': c_b_s, 'c_w_out': c_w_out,
            'ffn_w1': ffn_w1, 'ffn_w2': ffn_w2}


def reference(x, norm_mix, norm_ffn, norm_final, ab_w_in, diff_lq1, diff_lk1,
              diff_lq2, diff_lk2, diff_subln, lru_conv_w, lru_conv_b, lru_wa,
              lru_ba, lru_wx, lru_bx, lru_lambda, ab_w_out, c_w_in, c_ln_g, c_ln_b,
              c_w_s, c_b_s, c_w_out, ffn_w1, ffn_w2):
    splits = [DIFF_WIDTH, 2 * DIFF_WIDTH, 3 * DIFF_WIDTH, 3 * DIFF_WIDTH + LRU_WIDTH]
    for layer in range(DEPTH):
        h = rms_norm(x, norm_mix[layer])
        if layer % 2 == 0:
            e = layer // 2
            proj = h @ ab_w_in[e]
            q, k, v, xb, gate = jnp.split(proj, splits, axis=-1)
            lam_init = 0.8 - 0.6 * math.exp(-0.3 * layer)
            lam = (jnp.exp(jnp.sum(diff_lq1[e].astype(jnp.float32) * diff_lk1[e].astype(jnp.float32)))
                   - jnp.exp(jnp.sum(diff_lq2[e].astype(jnp.float32) * diff_lk2[e].astype(jnp.float32)))
                   + lam_init)
            ya = diff_attention(q, k, v, lam, lam_init, diff_subln[e])
            yb = rg_lru_branch(xb, gate, lru_conv_w[e], lru_conv_b[e], lru_wa[e], lru_ba[e],
                               lru_wx[e], lru_bx[e], lru_lambda[e])
            mix = jnp.concatenate([ya, yb], axis=-1) @ ab_w_out[e]
        else:
            o = layer // 2
            z = jax.nn.gelu(h @ c_w_in[o])
            mix = spatial_gating(z, c_ln_g[o], c_ln_b[o], c_w_s[o], c_b_s[o]) @ c_w_out[o]
        x = x + mix
        h = rms_norm(x, norm_ffn[layer])
        x = x + jnp.square(jax.nn.relu(h @ ffn_w1[layer])) @ ffn_w2[layer]
    return rms_norm(x, norm_final)
```

```cpp
#include <hip/hip_runtime.h>
#include <hip/hip_cooperative_groups.h>
#include <cstdio>
#include <cstdint>
namespace cg = cooperative_groups;
namespace pg8 {
#define PG8_LAS __attribute__((address_space(3)))
typedef unsigned short bf16_t;
typedef short bf16x8 __attribute__((ext_vector_type(8)));
typedef float f32x4 __attribute__((ext_vector_type(4)));
typedef unsigned u32x4 __attribute__((ext_vector_type(4)));
constexpr int BM = 256, BK = 64, HALF = 128, HTB = HALF * BK * 2  , STAGE_BYTES = 8 * HTB, NXCD = 8, WGM = 8;

__host__ __device__ __forceinline__ int lds_byte(int r, int c) { const int st = (r >> 4) * 2 + (c >> 5), rr = r & 15, cc = c & 31, ob = rr * 64 + cc * 2; return st * 1024 + (ob ^ (((ob >> 9) & 1) << 5)); }
__host__ __device__ __forceinline__ void stage_rc(int b, int& R, int& C) { const int st = b / 1024, sb = b % 1024, swz = sb ^ (((sb >> 9) & 1) << 5); R = (st >> 1) * 16 + swz / 64; C = (st & 1) * 32 + (swz % 64) / 2; }
__host__ __device__ __forceinline__ int perm32(int rho) { const int n = rho >> 4, i = rho & 15; return 8 * (i >> 2) + 4 * n + (i & 3); }

struct Unit { int pm, pn, ui; };
struct Gemm { const bf16_t* A; const bf16_t* Bt; int M, N, K; };

struct StaticOrder {
    int nM, nN, nwg, G, c;
    __host__ __device__ void init(int M, int N, int G_, int c_) { nM = M / BM; nN = N / BM; nwg = nM * nN; G = G_; c = c_; }
    __host__ __device__ bool next(int i, Unit& u) const {
        const long L = (long)i * G + c; if (L >= nwg) return false;
        int wgid = (int)L; { const int q = nwg / NXCD, r = nwg % NXCD, xcd = wgid % NXCD, off = wgid / NXCD; wgid = (xcd < r ? xcd * (q + 1) : r * (q + 1) + (xcd - r) * q) + off; }
        const int nig = WGM * nN, gid = wgid / nig, fm = gid * WGM, gsz = (nM - fm) < WGM ? (nM - fm) : WGM;
        u.pm = fm + ((wgid % nig) % gsz); u.pn = (wgid % nig) / gsz; u.ui = i; return true;
    }
    __device__ __forceinline__ void a_ready(const Unit&) const {}
    __device__ __forceinline__ void done(const Unit&) const {}
};

__device__ __forceinline__ unsigned cvt_pk_bf16(float lo, float hi) { unsigned r; asm volatile("v_cvt_pk_bf16_f32 %0, %1, %2" : "=v"(r) : "v"(lo), "v"(hi)); return r; }
typedef float f32x2v __attribute__((ext_vector_type(2)));
typedef unsigned u32x2v __attribute__((ext_vector_type(2)));
typedef __bf16 bf16x2_t __attribute__((ext_vector_type(2)));
__device__ __forceinline__ unsigned cvtpk(float lo, float hi) { f32x2v v = {lo, hi}; bf16x2_t b = __builtin_convertvector(v, bf16x2_t); return __builtin_bit_cast(unsigned, b); }
constexpr float RMS_EPS = 1e-6f;
__device__ __forceinline__ float gelu_tanh(float x) {
    const float u = x * (1.0f + 0.044715f * x * x);
    const float e = __builtin_amdgcn_exp2f(-2.302208198f * u);
    return x * __builtin_amdgcn_rcpf(1.0f + e);
}
__device__ __forceinline__ float rs_from_part(const float* part, int row) {
    const f32x4* pp = (const f32x4*)(part + (size_t)row * 16);
    const f32x4 a = pp[0], b = pp[1], c = pp[2], d = pp[3];
    const float s = ((a[0] + a[1]) + (a[2] + a[3])) + ((b[0] + b[1]) + (b[2] + b[3])) + ((c[0] + c[1]) + (c[2] + c[3])) + ((d[0] + d[1]) + (d[2] + d[3]));
    return rsqrtf(s * (1.0f / 1024.0f) + RMS_EPS);
}
template <int ACT, bool STATS, int GELU_PN = 99> struct EpiScaleAct {
    static constexpr bool PERM = true, AFTER_DRAIN = false;
    bf16_t* O; int ldc; const PG8_LAS float* rsl; f32x2v* lns;
    __device__ __forceinline__ void operator()(const f32x4 (&acc)[2][2][4][2], const Unit& u, int wr, int wc, int fr, int fq) const {
        const int row0 = u.pm * BM + wr * 64 + fr, col0 = u.pn * BM + wc * 32 + 8 * fq;
        float rs8[2][4];
#pragma unroll
        for (int ai = 0; ai < 2; ++ai)
#pragma unroll
            for (int m = 0; m < 4; ++m) rs8[ai][m] = rsl[u.ui * BM + wr * 64 + fr + ai * HALF + m * 16];
#pragma unroll
        for (int ai = 0; ai < 2; ++ai)
#pragma unroll
            for (int m = 0; m < 4; ++m) {
                const int row = row0 + ai * HALF + m * 16;
                const float rs = rs8[ai][m];
                bf16_t* rowp = O + (size_t)row * ldc + col0;
                float ssum = 0.f, ssq = 0.f;
#pragma unroll
                for (int bj = 0; bj < 2; ++bj) {
                    f32x4 v0 = acc[ai][bj][m][0] * rs, v1 = acc[ai][bj][m][1] * rs;
                    if (ACT == 1 || (GELU_PN < 99 && u.pn >= GELU_PN)) {
#pragma unroll
                        for (int e = 0; e < 4; ++e) { v0[e] = gelu_tanh(v0[e]); v1[e] = gelu_tanh(v1[e]); }
                    }
                    if (ACT == 2) {
#pragma unroll
                        for (int e = 0; e < 4; ++e) { const float a = fmaxf(v0[e], 0.f), b = fmaxf(v1[e], 0.f); v0[e] = a * a; v1[e] = b * b; }
                    }
                    if (STATS) {
#pragma unroll
                        for (int e = 0; e < 4; ++e) { ssum += v0[e] + v1[e]; ssq += v0[e] * v0[e] + v1[e] * v1[e]; }
                    }
                    u32x4 w; w.x = cvtpk(v0[0], v0[1]); w.y = cvtpk(v0[2], v0[3]); w.z = cvtpk(v1[0], v1[1]); w.w = cvtpk(v1[2], v1[3]);
                    if (ACT == 2) __builtin_nontemporal_store(w, (u32x4*)(rowp + bj * HALF));
                    else *(u32x4*)(rowp + bj * HALF) = w;
                }
                if (STATS) {
                    ssum += __shfl_xor(ssum, 16); ssum += __shfl_xor(ssum, 32);
                    ssq += __shfl_xor(ssq, 16); ssq += __shfl_xor(ssq, 32);
                    if (u.pn >= 4 && fq == 0) lns[(size_t)row * 16 + (u.pn - 4) * 4 + wc] = (f32x2v){ssum, ssq};
                }
            }
    }
};
struct EpiVT {
    static constexpr bool PERM = true, AFTER_DRAIN = false;
    bf16_t* O; int ldc; const PG8_LAS float* rsl;
    __device__ __forceinline__ void operator()(const f32x4 (&acc)[2][2][4][2], const Unit& u, int wr, int wc, int fr, int fq) const {
        const int row0 = u.pm * BM + wr * 64 + fr, col0 = u.pn * BM + wc * 32 + 8 * fq;
        f32x4 rsv[2][2];
#pragma unroll
        for (int bj = 0; bj < 2; ++bj)
#pragma unroll
            for (int n = 0; n < 2; ++n) rsv[bj][n] = *(const PG8_LAS f32x4*)(rsl + u.ui * BM + wc * 32 + 8 * fq + bj * HALF + 4 * n);
#pragma unroll
        for (int ai = 0; ai < 2; ++ai)
#pragma unroll
            for (int m = 0; m < 4; ++m) {
                const int row = row0 + ai * HALF + m * 16;
#pragma unroll
                for (int bj = 0; bj < 2; ++bj) {
                    const int tok = col0 + bj * HALF;
                    bf16_t* dst = O + ((((size_t)((tok >> 12) * 4 + (row >> 7)) * 64 + ((tok >> 6) & 63)) * 128 + (row & 127)) * 64 + (tok & 63));
                    const f32x4 v0 = acc[ai][bj][m][0] * rsv[bj][0], v1 = acc[ai][bj][m][1] * rsv[bj][1];
                    u32x4 w; w.x = cvtpk(v0[0], v0[1]); w.y = cvtpk(v0[2], v0[3]); w.z = cvtpk(v1[0], v1[1]); w.w = cvtpk(v1[2], v1[3]);
                    *(u32x4*)dst = w;
                }
            }
    }
};
struct EpiResid {
    static constexpr bool PERM = true, AFTER_DRAIN = false;
    bf16_t* xb; float* part;
    __device__ __forceinline__ void operator()(const f32x4 (&acc)[2][2][4][2], const Unit& u, int wr, int wc, int fr, int fq) const {
        const int row0 = u.pm * BM + wr * 64 + fr, col0 = u.pn * BM + wc * 32 + 8 * fq;
#pragma unroll
        for (int ai = 0; ai < 2; ++ai) {
            u32x4 old[4][2];
#pragma unroll
            for (int m = 0; m < 4; ++m)
#pragma unroll
                for (int bj = 0; bj < 2; ++bj) old[m][bj] = *(const u32x4*)(xb + (size_t)(row0 + ai * HALF + m * 16) * 1024 + col0 + bj * HALF);
            asm volatile("" ::: "memory");
#pragma unroll
            for (int m = 0; m < 4; ++m) {
                const int row = row0 + ai * HALF + m * 16;
                bf16_t* xp = xb + (size_t)row * 1024 + col0;
                float ss = 0.f;
#pragma unroll
                for (int bj = 0; bj < 2; ++bj) {
                    const u32x4 ov = old[m][bj];
                    f32x4 o0 = acc[ai][bj][m][0], o1 = acc[ai][bj][m][1];
                    o0[0] += __uint_as_float(ov.x << 16); o0[1] += __uint_as_float(ov.x & 0xffff0000u); o0[2] += __uint_as_float(ov.y << 16); o0[3] += __uint_as_float(ov.y & 0xffff0000u);
                    o1[0] += __uint_as_float(ov.z << 16); o1[1] += __uint_as_float(ov.z & 0xffff0000u); o1[2] += __uint_as_float(ov.w << 16); o1[3] += __uint_as_float(ov.w & 0xffff0000u);
                    ss += ((o0[0] * o0[0] + o0[1] * o0[1]) + (o0[2] * o0[2] + o0[3] * o0[3])) + ((o1[0] * o1[0] + o1[1] * o1[1]) + (o1[2] * o1[2] + o1[3] * o1[3]));
                    u32x4 w; w.x = cvtpk(o0[0], o0[1]); w.y = cvtpk(o0[2], o0[3]); w.z = cvtpk(o1[0], o1[1]); w.w = cvtpk(o1[2], o1[3]);
                    *(u32x4*)(xp + bj * HALF) = w;
                }
                ss += __shfl_xor(ss, 16); ss += __shfl_xor(ss, 32);
                if (fq == 0) part[(size_t)row * 16 + u.pn * 4 + wc] = ss;
            }
            asm volatile("" ::: "memory");
        }
    }
};
template <class Epi, class Sched, bool ALIGN_EPI = false, bool SP2 = false>
__device__ __forceinline__ void gemm_phase(PG8_LAS unsigned char* lds, const Gemm g, const Sched& S, const Epi& E) {
    int tid_ = threadIdx.x; asm volatile("" : "+v"(tid_));
    const int tid = tid_, wid = __builtin_amdgcn_readfirstlane(tid >> 6), lane = tid & 63, wr = wid >> 2, wc = wid & 3, fr = lane & 15, fq = lane >> 4;
    const int K = g.K, nt = K / BK;
    unsigned voffA[2], voffB[2];
#pragma unroll
    for (int i = 0; i < 2; ++i) { int R, C; stage_rc(tid * 16 + i * 8192, R, C); const int Rb = Epi::PERM ? ((R & ~31) + perm32(R & 31)) : R;
        voffA[i] = (unsigned)(R * K + C) * 2u; voffB[i] = (unsigned)(Rb * K + C) * 2u; }
    const size_t kstep = (size_t)(BK * 2);
    const size_t hstep = (size_t)HALF * K * 2;
    const size_t tstep = 2 * hstep;
    const unsigned ldsw = (unsigned)wid * 1024u;
    const int aoff = lds_byte(wr * 64 + fr, fq * 8), boff = lds_byte(wc * 32 + fr, fq * 8);
#define PG8_SA(b, h) (((b) * 2 + (h)) * HTB)
#define PG8_SB(b, h) ((4 + (b) * 2 + (h)) * HTB)
#define PG8_STAGE(bufoff, gbase, voff) do { _Pragma("unroll") for (int _i = 0; _i < 2; ++_i) \
        __builtin_amdgcn_global_load_lds((const unsigned*)((const char*)(gbase) + (voff)[_i]), (PG8_LAS unsigned*)(lds + (bufoff) + ldsw + _i * 8192), 16, 0, 0); } while (0)
#define PG8_LDA(dst, b, h) do { _Pragma("unroll") for (int m = 0; m < 4; ++m) _Pragma("unroll") for (int k = 0; k < 2; ++k) dst[m][k] = *(const PG8_LAS bf16x8*)(lds + PG8_SA(b, h) + aoff + m * 2048 + k * 1024); } while (0)
#define PG8_LDB(dst, b, h) do { _Pragma("unroll") for (int n = 0; n < 2; ++n) _Pragma("unroll") for (int k = 0; k < 2; ++k) dst[n][k] = *(const PG8_LAS bf16x8*)(lds + PG8_SB(b, h) + boff + n * 2048 + k * 1024); } while (0)
#define PG8_MMA(ai, bj, At, Bt) do { __builtin_amdgcn_s_setprio(1); _Pragma("unroll") for (int m = 0; m < 4; ++m) _Pragma("unroll") for (int n = 0; n < 2; ++n) _Pragma("unroll") for (int k = 0; k < 2; ++k) \
        acc[ai][bj][m][n] = __builtin_amdgcn_mfma_f32_16x16x32_bf16(Bt[n][k], At[m][k], acc[ai][bj][m][n], 0, 0, 0); __builtin_amdgcn_s_setprio(0); } while (0)
#define PG8_WAIT_V(n) asm volatile("s_waitcnt vmcnt(" #n ")" ::: "memory")
#define PG8_WAIT_L(n) asm volatile("s_waitcnt lgkmcnt(" #n ")" ::: "memory")
#define PG8_BAR __builtin_amdgcn_s_barrier()
#define PG8_SCHED __builtin_amdgcn_sched_barrier(0)
    Unit cur, nxt; int ui = 0;
    if (!S.next(0, cur)) return;
    f32x4 acc[2][2][4][2];
#pragma unroll
    for (int a = 0; a < 2; ++a)
#pragma unroll
        for (int b = 0; b < 2; ++b)
#pragma unroll
            for (int m = 0; m < 4; ++m)
#pragma unroll
                for (int n = 0; n < 2; ++n) acc[a][b][m][n] = (f32x4){0.f, 0.f, 0.f, 0.f};
    bf16x8 At[4][2], B0[2][2], B1[2][2];
    const char* cA = (const char*)g.A + (size_t)cur.pm * tstep; const char* cB = (const char*)g.Bt + (size_t)cur.pn * tstep;
    S.a_ready(cur);
    if constexpr (SP2) {
        PG8_STAGE(PG8_SB(0, 0), cB, voffB); PG8_STAGE(PG8_SB(0, 1), cB + hstep, voffB); PG8_STAGE(PG8_SA(0, 0), cA, voffA); PG8_STAGE(PG8_SA(0, 1), cA + hstep, voffA);
        if (wr == 1) PG8_BAR;
        PG8_WAIT_V(2); PG8_BAR;
        PG8_STAGE(PG8_SB(1, 0), cB + kstep, voffB); PG8_STAGE(PG8_SA(1, 0), cA + kstep, voffA); PG8_STAGE(PG8_SB(1, 1), cB + hstep + kstep, voffB);
        PG8_WAIT_V(6); PG8_BAR;
    } else {
        PG8_STAGE(PG8_SB(0, 0), cB, voffB); PG8_STAGE(PG8_SA(0, 0), cA, voffA); PG8_STAGE(PG8_SB(0, 1), cB + hstep, voffB); PG8_STAGE(PG8_SA(0, 1), cA + hstep, voffA);
        if (wr == 1) PG8_BAR;
        PG8_WAIT_V(4); PG8_BAR;
        PG8_STAGE(PG8_SB(1, 0), cB + kstep, voffB); PG8_STAGE(PG8_SA(1, 0), cA + kstep, voffA); PG8_STAGE(PG8_SB(1, 1), cB + hstep + kstep, voffB);
        PG8_WAIT_V(6); PG8_BAR;
    }
    for (;;) {
        const bool has_next = S.next(ui + 1, nxt);
        const char* nA = has_next ? (const char*)g.A + (size_t)nxt.pm * tstep : cA; const char* nB = has_next ? (const char*)g.Bt + (size_t)nxt.pn * tstep : cB;
        for (int t = 0; t < nt; t += 2) {
            const bool last = (t == nt - 2);
            const char* a1 = cA + (size_t)(t + 1) * kstep;
            const char* a2 = last ? nA : cA + (size_t)(t + 2) * kstep; const char* b2 = last ? nB : cB + (size_t)(t + 2) * kstep;
            const char* a3 = a2 + kstep; const char* b3 = b2 + kstep;
            if (last && has_next) S.a_ready(nxt);
            if constexpr (SP2) {
            PG8_LDB(B0, 0, 0); PG8_LDB(B1, 0, 1); PG8_SCHED; PG8_LDA(At, 0, 0); PG8_STAGE(PG8_SA(1, 1), a1 + hstep, voffA);
            PG8_WAIT_V(8); PG8_WAIT_L(0); PG8_BAR; PG8_MMA(0, 0, At, B0); PG8_MMA(0, 1, At, B1); PG8_BAR; PG8_SCHED;
            PG8_LDA(At, 0, 1); PG8_STAGE(PG8_SB(0, 0), b2, voffB); PG8_STAGE(PG8_SB(0, 1), b2 + hstep, voffB); PG8_STAGE(PG8_SA(0, 0), a2, voffA);
            PG8_WAIT_V(8); PG8_WAIT_L(0); PG8_BAR; PG8_MMA(1, 0, At, B0); PG8_MMA(1, 1, At, B1); PG8_BAR; PG8_SCHED;
            PG8_LDB(B0, 1, 0); PG8_LDB(B1, 1, 1); PG8_SCHED; PG8_LDA(At, 1, 0); PG8_STAGE(PG8_SA(0, 1), a2 + hstep, voffA);
            PG8_WAIT_V(8); PG8_WAIT_L(0); PG8_BAR; PG8_MMA(0, 0, At, B0); PG8_MMA(0, 1, At, B1); PG8_BAR; PG8_SCHED;
            PG8_LDA(At, 1, 1); PG8_STAGE(PG8_SB(1, 0), b3, voffB); PG8_STAGE(PG8_SB(1, 1), b3 + hstep, voffB); PG8_STAGE(PG8_SA(1, 0), a3, voffA);
            PG8_WAIT_V(8); PG8_WAIT_L(0); PG8_BAR; PG8_MMA(1, 0, At, B0); PG8_MMA(1, 1, At, B1); PG8_BAR; PG8_SCHED;
            } else {
            PG8_LDB(B0, 0, 0); PG8_SCHED; PG8_LDA(At, 0, 0); PG8_STAGE(PG8_SA(1, 1), a1 + hstep, voffA);
            PG8_WAIT_L(8); PG8_BAR; PG8_WAIT_L(0); PG8_MMA(0, 0, At, B0); PG8_BAR; PG8_SCHED;
            PG8_LDB(B1, 0, 1); PG8_STAGE(PG8_SB(0, 0), b2, voffB);
            PG8_BAR; PG8_WAIT_L(0); PG8_MMA(0, 1, At, B1); PG8_BAR;
            PG8_LDA(At, 0, 1); PG8_STAGE(PG8_SA(0, 0), a2, voffA);
            PG8_BAR; PG8_WAIT_L(0); PG8_MMA(1, 0, At, B0); PG8_BAR; PG8_SCHED;
            PG8_STAGE(PG8_SB(0, 1), b2 + hstep, voffB);
            PG8_WAIT_V(6); PG8_BAR; PG8_MMA(1, 1, At, B1); PG8_BAR;
            PG8_LDB(B0, 1, 0); PG8_SCHED; PG8_LDA(At, 1, 0); PG8_STAGE(PG8_SA(0, 1), a2 + hstep, voffA);
            PG8_WAIT_L(8); PG8_BAR; PG8_WAIT_L(0); PG8_MMA(0, 0, At, B0); PG8_BAR; PG8_SCHED;
            PG8_LDB(B1, 1, 1); PG8_STAGE(PG8_SB(1, 0), b3, voffB);
            PG8_BAR; PG8_WAIT_L(0); PG8_MMA(0, 1, At, B1); PG8_BAR;
            PG8_LDA(At, 1, 1); PG8_STAGE(PG8_SA(1, 0), a3, voffA);
            PG8_BAR; PG8_WAIT_L(0); PG8_MMA(1, 0, At, B0); PG8_BAR; PG8_SCHED;
            PG8_STAGE(PG8_SB(1, 1), b3 + hstep, voffB);
            PG8_WAIT_V(6); PG8_BAR; PG8_MMA(1, 1, At, B1); PG8_BAR;
            }
        }
        if constexpr (ALIGN_EPI) { if (wr == 0) PG8_BAR; }
        if constexpr (!Epi::AFTER_DRAIN) { E(acc, cur, wr, wc, fr, fq); S.done(cur); }
        if (!has_next) break;
#pragma unroll
        for (int a = 0; a < 2; ++a)
#pragma unroll
            for (int b = 0; b < 2; ++b)
#pragma unroll
                for (int m = 0; m < 4; ++m)
#pragma unroll
                    for (int n = 0; n < 2; ++n) acc[a][b][m][n] = (f32x4){0.f, 0.f, 0.f, 0.f};
        cur = nxt; cA = nA; cB = nB; ++ui;
        if constexpr (ALIGN_EPI) { if (wr == 1) PG8_BAR; }
    }
    PG8_WAIT_V(0);
    if constexpr (!ALIGN_EPI) { if (wr == 0) PG8_BAR; }
    PG8_BAR;
    if constexpr (Epi::AFTER_DRAIN) { E.fused(acc, cur, wr, wc, fr, fq, lds, wid, lane); S.done(cur); }
#undef PG8_SA
#undef PG8_SB
#undef PG8_STAGE
#undef PG8_LDA
#undef PG8_LDB
#undef PG8_MMA
#undef PG8_WAIT_V
#undef PG8_WAIT_L
#undef PG8_BAR
#undef PG8_SCHED
}
}
#define LAS __attribute__((address_space(3)))
typedef unsigned short bf16_t;
typedef short bf16x8 __attribute__((ext_vector_type(8)));
typedef float f32x4 __attribute__((ext_vector_type(4)));
typedef float f32x16 __attribute__((ext_vector_type(16)));
typedef unsigned u32x4 __attribute__((ext_vector_type(4)));
typedef unsigned u32x2 __attribute__((ext_vector_type(2)));
typedef float f32x2 __attribute__((ext_vector_type(2)));
using pg8::cvtpk; using pg8::gelu_tanh; using pg8::RMS_EPS;
constexpr int NB = 8, SEQ = 4096, DM = 1024, MTOK = NB * SEQ, DFF = 4096;
constexpr int PROJ_LD = 2048;
constexpr float QK_C2 = 0.125f * 1.4426950408889634f;
constexpr size_t MiB = 1u << 20;
constexpr size_t WS_CTL = 0;
constexpr size_t WS_PART = 1 * MiB;
constexpr size_t WS_LNS = 3 * MiB;
constexpr size_t WS_SMALL = 7 * MiB;
constexpr size_t SM_LRUW = 0;
constexpr size_t SM_WS = 256 * 1024;
constexpr size_t SM_LAM = 768 * 1024;
constexpr size_t WS_WIN = 8 * MiB;
constexpr size_t WS_WOUT = 18 * MiB;
constexpr size_t WS_CIN = 22 * MiB;
constexpr size_t WS_COUT = 30 * MiB;
constexpr size_t WS_W1 = 34 * MiB;
constexpr size_t WS_W2 = 66 * MiB;
constexpr size_t WS_XB = 98 * MiB;
constexpr size_t WS_Y = 162 * MiB;
constexpr size_t WS_H = 226 * MiB;
constexpr size_t WS_VT = WS_H + 128 * MiB;
constexpr size_t WS_END = 482 * MiB;
constexpr int LDS_BYTES = 147456;
constexpr int LDS_CTL = 146432;
constexpr int N_LRU_UNITS = 64, N_ATT_UNITS = NB * 4 * 32;

struct Params { const float* in[26]; float* out; unsigned char* ws; };

__device__ __forceinline__ float bf2f(unsigned short b) { return __uint_as_float((unsigned)b << 16); }
__device__ __forceinline__ float wave_sum(float v) {
#pragma unroll
    for (int o = 1; o < 64; o <<= 1) v += __shfl_xor(v, o);
    return v;
}
__device__ __forceinline__ float xhalf_max(float v) { auto rr = __builtin_amdgcn_permlane32_swap(__float_as_uint(v), __float_as_uint(v), false, false); return fmaxf(__uint_as_float(rr[0]), __uint_as_float(rr[1])); }
__device__ __forceinline__ float xhalf_sum(float v) { auto rr = __builtin_amdgcn_permlane32_swap(__float_as_uint(v), __float_as_uint(v), false, false); return __uint_as_float(rr[0]) + __uint_as_float(rr[1]); }
__device__ __forceinline__ float max3f(float a, float b, float c) { float r; asm("v_max3_f32 %0, %1, %2, %3" : "=v"(r) : "v"(a), "v"(b), "v"(c)); return r; }
__device__ __forceinline__ int crow(int i, int h) { return (i & 3) + 8 * (i >> 2) + 4 * h; }
#define MFMA32(a, b, c) __builtin_amdgcn_mfma_f32_32x32x16_bf16((a), (b), (c), 0, 0, 0)
#define WG_BAR() __syncthreads()

#define XB_TMO      128
#define XB_XCNT(j)  (256  + 64 * (j))
#define XB_XSUB(j)  (1280 + 64 * (j))
#define XB_XGEN(j)  (2304 + 64 * (j))
#define XB_TOP      3328
#define XB_TOPGEN   3392
#define XCD_BAR_WORDS 3456
#define XB_SPIN_CAP (1u << 23)

__device__ __forceinline__ unsigned xb_ld(unsigned* p)              { return __hip_atomic_load(p, __ATOMIC_RELAXED, __HIP_MEMORY_SCOPE_AGENT); }
__device__ __forceinline__ unsigned xb_add(unsigned* p, unsigned v) { return __hip_atomic_fetch_add(p, v, __ATOMIC_RELAXED, __HIP_MEMORY_SCOPE_AGENT); }
__device__ __forceinline__ unsigned xb_xcc_id() { return (unsigned)__builtin_amdgcn_s_getreg((3 << 11) | 20) & 0xFu; }
#define XB_SPIN(cond, bar) do { unsigned _sp = 0; while (cond) { __builtin_amdgcn_s_sleep(1); \
    if ((++_sp & 255u) == 0u) { if (xb_ld(&(bar)[XB_TMO])) break; if (_sp > XB_SPIN_CAP) { atomicAdd(&(bar)[XB_TMO], 1u); break; } } } } while (0)

struct XcdBarrier {
    unsigned* bar; unsigned x;
    volatile LAS unsigned* st;
};

__device__ __forceinline__ XcdBarrier xcd_barrier_post(unsigned* bar, volatile LAS unsigned* st) {
    XcdBarrier b; b.bar = bar; b.x = xb_xcc_id(); b.st = st;
    if (threadIdx.x == 0) (void)xb_add(&bar[XB_XCNT(b.x)], 1u);
    return b;
}
__device__ __forceinline__ void xcd_barrier_complete(unsigned* bar, unsigned x, unsigned& nloc, unsigned& nx) {
    const unsigned G = gridDim.x * gridDim.y * gridDim.z;
    unsigned sum, cnt, mine, sp = 0u;
    for (;;) {
        sum = 0u; cnt = 0u; mine = 0u;
#pragma unroll
        for (unsigned j = 0; j < 16; ++j) { const unsigned c = xb_ld(&bar[XB_XCNT(j)]); sum += c; cnt += (c > 0u) ? 1u : 0u; mine = (j == x) ? c : mine; }
        if (sum == G) break;
        __builtin_amdgcn_s_sleep(1);
        if ((++sp & 255u) == 0u) { if (xb_ld(&bar[XB_TMO])) break; if (sp > XB_SPIN_CAP) { atomicAdd(&bar[XB_TMO], 1u); break; } }
    }
    nloc = mine > 0u ? mine : 1u; nx = cnt > 0u ? cnt : 1u;
}

__device__ __forceinline__ void xcd_barrier(const XcdBarrier& b) {
    asm volatile("s_waitcnt vmcnt(0)" ::: "memory");
    __syncthreads();
    if (threadIdx.x == 0) {
        unsigned* bar = b.bar;
        __builtin_amdgcn_s_waitcnt(0);
        unsigned nloc = b.st[0], nx = b.st[1];
        if (nloc == 0u) { xcd_barrier_complete(bar, b.x, nloc, nx); b.st[0] = nloc; b.st[1] = nx; }
        const unsigned old = xb_add(&bar[XB_XSUB(b.x)], 1u);
        const unsigned gen = old / nloc;
        if (old + 1u == (gen + 1u) * nloc) {
            __builtin_amdgcn_fence(__ATOMIC_RELEASE, "agent");
            asm volatile("s_waitcnt vmcnt(0)" ::: "memory");
            const unsigned og = xb_add(&bar[XB_TOP], 1u);
            const unsigned tg = og / nx;
            if (og + 1u == (tg + 1u) * nx) xb_add(&bar[XB_TOPGEN], 1u);
            else XB_SPIN(xb_ld(&bar[XB_TOPGEN]) == tg, bar);
            __builtin_amdgcn_fence(__ATOMIC_ACQUIRE, "agent");
            xb_add(&bar[XB_XGEN(b.x)], 1u);
            asm volatile("s_waitcnt vmcnt(0)" ::: "memory");
        } else {
            XB_SPIN(xb_ld(&bar[XB_XGEN(b.x)]) == gen, bar);
            __builtin_amdgcn_fence(__ATOMIC_ACQUIRE, "agent");
            asm volatile("s_waitcnt vmcnt(0)" ::: "memory");
        }
    }
    __syncthreads();
}

constexpr int CW_BAR = 16384;

struct P0Item { const float* W; bf16_t* WT; const float* gain; int K, N, k0, n0, r0; float cs; };
__device__ __forceinline__ P0Item p0_decode(const Params& P, unsigned char* ws, int it) {
    constexpr int I_WIN = 16 * 80, I_WOUT = 16 * 32, I_CIN = 16 * 64, I_COUT = 16 * 32, I_W1 = 16 * 128, I_W2 = 64 * 32;
    constexpr int T0 = 2 * I_WIN, T1 = T0 + 2 * I_WOUT, T2 = T1 + 2 * I_CIN, T3 = T2 + 2 * I_COUT, T4 = T3 + 4 * I_W1;
    P0Item d; int mode = 0, item;
    if (it < T0) { const int e = it / I_WIN; item = it % I_WIN; d.W = P.in[4] + (size_t)e * 1024 * 2560; d.K = 1024; d.N = 2560; d.WT = (bf16_t*)(ws + WS_WIN) + (size_t)e * 2560 * 1024; d.gain = P.in[1] + (2 * e) * 1024; mode = 1; }
    else if (it < T1) { const int e = (it - T0) / I_WOUT; item = (it - T0) % I_WOUT; d.W = P.in[17] + (size_t)e * 1024 * 1024; d.K = 1024; d.N = 1024; d.WT = (bf16_t*)(ws + WS_WOUT) + (size_t)e * 1024 * 1024; d.gain = nullptr; }
    else if (it < T2) { const int o = (it - T1) / I_CIN; item = (it - T1) % I_CIN; d.W = P.in[18] + (size_t)o * 1024 * 2048; d.K = 1024; d.N = 2048; d.WT = (bf16_t*)(ws + WS_CIN) + (size_t)o * 2048 * 1024; d.gain = P.in[1] + (2 * o + 1) * 1024; }
    else if (it < T3) { const int o = (it - T2) / I_COUT; item = (it - T2) % I_COUT; d.W = P.in[23] + (size_t)o * 1024 * 1024; d.K = 1024; d.N = 1024; d.WT = (bf16_t*)(ws + WS_COUT) + (size_t)o * 1024 * 1024; d.gain = nullptr; }
    else if (it < T4) { const int l = (it - T3) / I_W1; item = (it - T3) % I_W1; d.W = P.in[24] + (size_t)l * 1024 * 4096; d.K = 1024; d.N = 4096; d.WT = (bf16_t*)(ws + WS_W1) + (size_t)l * 4096 * 1024; d.gain = P.in[2] + l * 1024; }
    else { const int l = (it - T4) / I_W2; item = (it - T4) % I_W2; d.W = P.in[25] + (size_t)l * 4096 * 1024; d.K = 4096; d.N = 1024; d.WT = (bf16_t*)(ws + WS_W2) + (size_t)l * 1024 * 4096; d.gain = nullptr; }
    const int nblk = d.N / 32, kb = item / nblk, nb = item % nblk; d.k0 = 64 * kb; d.n0 = 32 * nb; d.cs = 1.0f; d.r0 = d.n0;
    if (mode == 1) { if (d.n0 < 512) d.cs = QK_C2; d.r0 = (d.n0 < 1024) ? d.n0 : ((d.n0 < 1536) ? d.n0 + 1024 : d.n0 - 512); }
    return d;
}
__device__ __forceinline__ void p0_load(const P0Item& d, int lane, f32x4 (&v)[8], float (&g)[8]) {
#pragma unroll
    for (int i = 0; i < 8; ++i) { const int kk = 8 * i + (lane >> 3), c4 = lane & 7;
        v[i] = __builtin_nontemporal_load((const f32x4*)(d.W + (size_t)(d.k0 + kk) * d.N + d.n0 + 4 * c4));
        g[i] = d.gain ? d.gain[d.k0 + kk] * d.cs : d.cs; }
}
__device__ __forceinline__ void p0_store(const P0Item& d, int lane, const f32x4 (&v)[8], const float (&g)[8], LAS float* scr) {
#pragma unroll
    for (int i = 0; i < 8; ++i) { const int kk = 8 * i + (lane >> 3), c4 = lane & 7;
        scr[kk * 33 + 4 * c4 + 0] = v[i][0] * g[i]; scr[kk * 33 + 4 * c4 + 1] = v[i][1] * g[i]; scr[kk * 33 + 4 * c4 + 2] = v[i][2] * g[i]; scr[kk * 33 + 4 * c4 + 3] = v[i][3] * g[i]; }
    asm volatile("s_waitcnt lgkmcnt(0)" ::: "memory");
    const int c = lane & 7;
#pragma unroll
    for (int j = 0; j < 4; ++j) { const int n = (lane >> 3) + 8 * j; const LAS float* s = scr + (8 * c) * 33 + n;
        u32x4 o; o.x = cvtpk(s[0 * 33], s[1 * 33]); o.y = cvtpk(s[2 * 33], s[3 * 33]); o.z = cvtpk(s[4 * 33], s[5 * 33]); o.w = cvtpk(s[6 * 33], s[7 * 33]);
        __builtin_nontemporal_store(o, (u32x4*)(d.WT + (size_t)(d.r0 + n) * d.K + d.k0 + 8 * c)); }
    asm volatile("s_waitcnt lgkmcnt(0)" ::: "memory");
}
__device__ __forceinline__ void prologue_phase(const Params& P, LAS unsigned char* lds) {
    int tid_ = threadIdx.x; asm volatile("" : "+v"(tid_));
    const int tid = tid_, lane = tid & 63, wave = tid >> 6;
    const int gw = blockIdx.x * 8 + wave, NGW = gridDim.x * 8;
    const int gt = blockIdx.x * 512 + tid, NGT = gridDim.x * 512;
    unsigned char* ws = P.ws;
    if (gt < 64) ((unsigned*)(ws + WS_CTL))[gt] = 0u;
    if (gt < XCD_BAR_WORDS) ((unsigned*)(ws + WS_CTL))[CW_BAR + gt] = 0u;
    if (blockIdx.x == 0 && wave < 2) {
        const int e = wave;
        const float a = wave_sum(P.in[5][e * 64 + lane] * P.in[6][e * 64 + lane]);
        const float b = wave_sum(P.in[7][e * 64 + lane] * P.in[8][e * 64 + lane]);
        const float lam_init = (e == 0) ? 0.2f : (0.8f - 0.6f * 0.54881163609f);
        if (lane == 0) ((float*)(ws + WS_SMALL + SM_LAM))[e] = expf(a) - expf(b) + lam_init;
    }
    {
        bf16_t* dst = (bf16_t*)(ws + WS_SMALL + SM_LRUW);
        for (int t = gt; t < 2 * 2 * 8 * 4096; t += NGT) {
            const int i = t & 63, j = (t >> 6) & 63, h = (t >> 12) & 7, mat = (t >> 15) & 1, e = t >> 16;
            const float v = P.in[mat ? 14 : 12][((size_t)(e * 8 + h) * 64 + i) * 64 + j];
            dst[t] = (bf16_t)(cvtpk(v * -1.4426950408889634f, 0.f) & 0xffffu);
        }
    }
    {
        bf16_t* dst = (bf16_t*)(ws + WS_SMALL + SM_WS);
        for (int t = gt; t < 2 * 8 * 128 * 128; t += NGT) {
            const int q = t & 127, p = (t >> 7) & 127;
            const float v = ((q >> 6) <= (p >> 6)) ? P.in[21][t] : 0.f;
            dst[t] = (bf16_t)(cvtpk(v, 0.f) & 0xffffu);
        }
    }
    {
        LAS float* scr = (LAS float*)(lds + wave * 16384);
        constexpr int NITEMS = 2 * 16 * 80 + 2 * 16 * 32 + 2 * 16 * 64 + 2 * 16 * 32 + 4 * 16 * 128 + 4 * 64 * 32;
        int it = gw; P0Item d; f32x4 v[8]; float g[8];
        if (it < NITEMS) { d = p0_decode(P, ws, it); p0_load(d, lane, v, g); }
        while (it < NITEMS) {
            const int itn = it + NGW; P0Item dn = d; f32x4 vn[8]; float gn[8];
#pragma unroll
            for (int i = 0; i < 8; ++i) { vn[i] = v[i]; gn[i] = g[i]; }
            if (itn < NITEMS) { dn = p0_decode(P, ws, itn); p0_load(dn, lane, vn, gn); }
            p0_store(d, lane, v, g, scr);
            d = dn; it = itn;
#pragma unroll
            for (int i = 0; i < 8; ++i) { v[i] = vn[i]; g[i] = gn[i]; }
        }
    }
    {
        const float* x = P.in[0]; bf16_t* xb = (bf16_t*)(ws + WS_XB); float* part = (float*)(ws + WS_PART);
        for (int m = gw; m < MTOK; m += 2 * NGW) {
            const int m1 = m + NGW;
            const bool two = m1 < MTOK;
            const f32x4* xr0 = (const f32x4*)(x + (size_t)m * DM) + lane;
            const f32x4* xr1 = (const f32x4*)(x + (size_t)(two ? m1 : m) * DM) + lane;
            f32x4 v0[4], v1[4]; float s0 = 0.f, s1 = 0.f;
#pragma unroll
            for (int j = 0; j < 4; ++j) { v0[j] = __builtin_nontemporal_load(xr0 + 64 * j); v1[j] = __builtin_nontemporal_load(xr1 + 64 * j); }
#pragma unroll
            for (int j = 0; j < 4; ++j) { s0 += (v0[j][0] * v0[j][0] + v0[j][1] * v0[j][1]) + (v0[j][2] * v0[j][2] + v0[j][3] * v0[j][3]);
                                          s1 += (v1[j][0] * v1[j][0] + v1[j][1] * v1[j][1]) + (v1[j][2] * v1[j][2] + v1[j][3] * v1[j][3]); }
            s0 = wave_sum(s0); s1 = wave_sum(s1);
            u32x2* o0 = (u32x2*)(xb + (size_t)m * DM) + lane;
#pragma unroll
            for (int j = 0; j < 4; ++j) { u32x2 w; w.x = cvtpk(v0[j][0], v0[j][1]); w.y = cvtpk(v0[j][2], v0[j][3]); o0[64 * j] = w; }
            if (lane < 16) part[(size_t)m * 16 + lane] = s0 * (1.0f / 16.0f);
            if (two) {
                u32x2* o1 = (u32x2*)(xb + (size_t)m1 * DM) + lane;
#pragma unroll
                for (int j = 0; j < 4; ++j) { u32x2 w; w.x = cvtpk(v1[j][0], v1[j][1]); w.y = cvtpk(v1[j][2], v1[j][3]); o1[64 * j] = w; }
                if (lane < 16) part[(size_t)m1 * 16 + lane] = s1 * (1.0f / 16.0f);
            }
        }
    }
}

constexpr int AT_KS = 272, AT_VS = 144, AT_KBYTES = 64 * AT_KS, AT_VBYTES = 128 * AT_VS, AT_BUF = AT_KBYTES + AT_VBYTES;
__device__ __forceinline__ void attn_unit(const bf16_t* __restrict__ proj, const bf16_t* __restrict__ vt, bf16_t* __restrict__ Y, const float* __restrict__ subln, float lam, float out_scale,
                                          int b, int h, int qb, unsigned* qnext, unsigned& pre, LAS unsigned char* lds) {
    int tid_ = threadIdx.x; asm volatile("" : "+v"(tid_));
    const int tid = tid_, lane = tid & 63, w = __builtin_amdgcn_readfirstlane(tid >> 6), r = lane & 31, hh = lane >> 5;
    const int mp = w & 1, jg = w >> 1;
    const size_t rowbase = (size_t)b * SEQ;
    const int NT = 2 * qb + 2, cw = 2 * qb + (jg >> 1);
    bf16x8 qf[4];
    { const bf16_t* qp = proj + (rowbase + qb * 128 + jg * 32 + r) * PROJ_LD + h * 128 + mp * 64 + hh * 8;
#pragma unroll
      for (int ks = 0; ks < 4; ++ks) qf[ks] = *(const bf16x8*)(qp + ks * 16); }
    const char* kgb = (const char*)(proj + rowbase * PROJ_LD + 512 + h * 128);
    const char* vgb = (const char*)(vt + (size_t)(b * 4 + h) * 64 * 128 * 64);
    unsigned kg[2], vg[2]; int kl[2], vl[2];
#pragma unroll
    for (int i = 0; i < 2; ++i) { const int c = tid + 512 * i;
        kg[i] = (unsigned)((c >> 4) * PROJ_LD + (c & 15) * 8) * 2u; kl[i] = (c >> 4) * AT_KS + (c & 15) * 16;
        vg[i] = (unsigned)((c >> 3) * 64 + (c & 7) * 8) * 2u; vl[i] = AT_KBYTES + (c >> 3) * AT_VS + (c & 7) * 16; }
    const int pir = (r & 3) + 4 * ((r >> 3) & 1) + 8 * ((r >> 2) & 1) + 16 * (r >> 4);
    const int kbase = pir * AT_KS + mp * 128 + hh * 16, vbase = AT_KBYTES + r * AT_VS + hh * 16;
    u32x4 kreg[2], vreg[2];
#pragma unroll
    for (int i = 0; i < 2; ++i) { kreg[i] = *(const u32x4*)(kgb + kg[i]); vreg[i] = *(const u32x4*)(vgb + vg[i]); }
#pragma unroll
    for (int i = 0; i < 2; ++i) { *(LAS u32x4*)(lds + kl[i]) = kreg[i]; *(LAS u32x4*)(lds + vl[i]) = vreg[i]; }
    WG_BAR();
    float m_run = 0.f, l_run = 0.f;
    asm volatile("" : "+v"(m_run));
    f32x16 o[4];
#pragma unroll
    for (int nb = 0; nb < 4; ++nb)
#pragma unroll
        for (int i = 0; i < 16; ++i) o[nb][i] = 0.f;
    for (int t = 0; t < NT; ++t) {
        const int boff = (t & 1) * AT_BUF, noff = ((t + 1) & 1) * AT_BUF;
        const bool more = (t + 1 < NT);
        if (more) {
#pragma unroll
            for (int i = 0; i < 2; ++i) { kreg[i] = *(const u32x4*)(kgb + (kg[i] + (unsigned)(t + 1) * (64u * PROJ_LD * 2u))); vreg[i] = *(const u32x4*)(vgb + (vg[i] + (unsigned)(t + 1) * 16384u)); }
        }
        if (t <= cw) {
            f32x16 s0, s1;
#pragma unroll
            for (int i = 0; i < 16; ++i) { s0[i] = 0.f; s1[i] = 0.f; }
            const LAS unsigned char* kb = lds + boff + kbase;
            const LAS unsigned char* vb = lds + boff + vbase;
            bf16x8 kf0[4], kf1[4];
#pragma unroll
            for (int ks = 0; ks < 4; ++ks) { kf0[ks] = *(const LAS bf16x8*)(kb + ks * 32); kf1[ks] = *(const LAS bf16x8*)(kb + 32 * AT_KS + ks * 32); }
            __builtin_amdgcn_sched_barrier(0);
#pragma unroll
            for (int ks = 0; ks < 4; ++ks) { s0 = MFMA32(kf0[ks], qf[ks], s0); s1 = MFMA32(kf1[ks], qf[ks], s1); }
            bf16x8 vf[16];
#pragma unroll
            for (int nb = 0; nb < 4; ++nb)
#pragma unroll
                for (int kk = 0; kk < 4; ++kk) vf[nb * 4 + kk] = *(const LAS bf16x8*)(vb + nb * 32 * AT_VS + kk * 32);
            __builtin_amdgcn_sched_barrier(0);
#pragma unroll
            for (int i = 0; i < 16; ++i) { s0[i] -= m_run; s1[i] -= m_run; }
            float mxa = max3f(s0[0], s0[1], s0[2]), mxb = max3f(s1[0], s1[1], s1[2]);
#pragma unroll
            for (int i = 3; i < 15; i += 2) { mxa = max3f(mxa, s0[i], s0[i + 1]); mxb = max3f(mxb, s1[i], s1[i + 1]); }
            float mx = max3f(mxa, mxb, s0[15]); mx = max3f(mx, s1[15], s1[15]);
            mx = xhalf_max(mx);
            const bool upd = (t == 0) || (mx > 8.0f);
            if (__any(upd)) {
                const float dl = upd ? mx : 0.f;
                m_run += dl;
#pragma unroll
                for (int i = 0; i < 16; ++i) { s0[i] -= dl; s1[i] -= dl; }
                if (t != 0) {
                    const float alpha = __builtin_amdgcn_exp2f(-dl);
                    l_run *= alpha;
#pragma unroll
                    for (int nb = 0; nb < 4; ++nb)
#pragma unroll
                        for (int i = 0; i < 16; ++i) o[nb][i] *= alpha;
                }
            }
            float ps = 0.f;
            bf16x8 pf[4];
#define AT_EXPQ(S, B, K) do { _Pragma("unroll") for (int i_ = 0; i_ < 8; ++i_) { S[(B) + i_] = __builtin_amdgcn_exp2f(S[(B) + i_]); ps += S[(B) + i_]; } \
              u32x4 a_; a_.x = cvtpk(S[(B) + 0], S[(B) + 1]); a_.y = cvtpk(S[(B) + 2], S[(B) + 3]); a_.z = cvtpk(S[(B) + 4], S[(B) + 5]); a_.w = cvtpk(S[(B) + 6], S[(B) + 7]); pf[K] = __builtin_bit_cast(bf16x8, a_); } while (0)
#define AT_PVQ(K) do { _Pragma("unroll") for (int nb_ = 0; nb_ < 4; ++nb_) o[nb_] = MFMA32(vf[nb_ * 4 + (K)], pf[K], o[nb_]); } while (0)
#define AT_MIX() do { _Pragma("unroll") for (int g_ = 0; g_ < 4; ++g_) { __builtin_amdgcn_sched_group_barrier(0x008, 1, 0); __builtin_amdgcn_sched_group_barrier(0x402, 7, 0); } __builtin_amdgcn_sched_barrier(0); } while (0)
            AT_EXPQ(s0, 0, 0);
            __builtin_amdgcn_sched_barrier(0);
            AT_PVQ(0); AT_EXPQ(s0, 8, 1); AT_MIX();
            AT_PVQ(1); AT_EXPQ(s1, 0, 2); AT_MIX();
            AT_PVQ(2); AT_EXPQ(s1, 8, 3); AT_MIX();
            AT_PVQ(3);
#undef AT_EXPQ
#undef AT_PVQ
#undef AT_MIX
            l_run += ps;
        }
        if (more) {
#pragma unroll
            for (int i = 0; i < 2; ++i) { *(LAS u32x4*)(lds + noff + kl[i]) = kreg[i]; *(LAS u32x4*)(lds + noff + vl[i]) = vreg[i]; }
        }
        WG_BAR();
    }
    if (tid == 0) pre = atomicAdd(qnext, 1u);
    const float l_tot = xhalf_sum(l_run);
    const float inv = 1.0f / l_tot;
    LAS float* ex = (LAS float*)lds + jg * 4096;
    if (mp == 1) {
        const float sc = lam * inv;
#pragma unroll
        for (int nb = 0; nb < 4; ++nb)
#pragma unroll
            for (int i = 0; i < 16; ++i) ex[(nb * 16 + i) * 64 + lane] = o[nb][i] * sc;
    }
    WG_BAR();
    if (mp == 0) {
        float ss = 0.f;
#pragma unroll
        for (int nb = 0; nb < 4; ++nb)
#pragma unroll
            for (int i = 0; i < 16; ++i) { const float d = o[nb][i] * inv - ex[(nb * 16 + i) * 64 + lane]; o[nb][i] = d; ss += d * d; }
        ss = xhalf_sum(ss);
        const float rstd = rsqrtf(ss * (1.0f / 128.0f) + RMS_EPS) * out_scale;
        bf16_t* yp = Y + (rowbase + qb * 128 + jg * 32 + r) * DM + h * 128 + 4 * hh;
#pragma unroll
        for (int nb = 0; nb < 4; ++nb)
#pragma unroll
            for (int g4 = 0; g4 < 4; ++g4) {
                const int n0 = 32 * nb + 8 * g4;
                const f32x4 gg = *(const f32x4*)(subln + n0 + 4 * hh);
                u32x2 wv; wv.x = cvtpk(o[nb][4 * g4 + 0] * rstd * gg[0], o[nb][4 * g4 + 1] * rstd * gg[1]); wv.y = cvtpk(o[nb][4 * g4 + 2] * rstd * gg[2], o[nb][4 * g4 + 3] * rstd * gg[3]);
                *(u32x2*)(yp + n0) = wv;
            }
    }
    WG_BAR();
}

constexpr int LR_XS = 68;
constexpr int LR_WAVE_BYTES = 32 * LR_XS * 4 + 32 * 64 * 4;
constexpr int LR_CW_OFF = 8 * LR_WAVE_BYTES;
typedef short s16x2_t __attribute__((ext_vector_type(2)));
__device__ __forceinline__ float ldbf(const char* p) { s16x2_t t = {0, *(const short*)p}; return __builtin_bit_cast(float, t); }
__device__ __forceinline__ float sigmoidf_(float x) { return __builtin_amdgcn_rcpf(1.0f + __builtin_amdgcn_exp2f(-1.4426950408889634f * x)); }
__device__ __forceinline__ void lru_unit(const Params& P, int e, int b, int hd, LAS unsigned char* lds) {
    int tid_ = threadIdx.x; asm volatile("" : "+v"(tid_));
    const int tid = tid_, lane = tid & 63, w = __builtin_amdgcn_readfirstlane(tid >> 6), r = lane & 31, hh = lane >> 5;
    const bf16_t* proj = (const bf16_t*)(P.ws + WS_H); bf16_t* Y = (bf16_t*)(P.ws + WS_Y);
    const size_t rowbase = (size_t)b * SEQ;
    const int chg = hd * 64 + lane;
    bf16x8 waf[2][4], wxf[2][4];
    { const bf16_t* wt = (const bf16_t*)(P.ws + WS_SMALL + SM_LRUW) + (size_t)e * 2 * 8 * 4096;
#pragma unroll
      for (int nt = 0; nt < 2; ++nt)
#pragma unroll
          for (int ks = 0; ks < 4; ++ks) {
              waf[nt][ks] = *(const bf16x8*)(wt + (size_t)(0 * 8 + hd) * 4096 + (32 * nt + r) * 64 + 16 * ks + 8 * hh);
              wxf[nt][ks] = *(const bf16x8*)(wt + (size_t)(1 * 8 + hd) * 4096 + (32 * nt + r) * 64 + 16 * ks + 8 * hh);
          } }
    float ba_[2], bx_[2], c8_[2];
#pragma unroll
    for (int nt = 0; nt < 2; ++nt) { const int c = e * 512 + hd * 64 + 32 * nt + r; ba_[nt] = -1.4426950408889634f * P.in[13][c]; bx_[nt] = -1.4426950408889634f * P.in[15][c];
        c8_[nt] = -8.0f * 1.4426950408889634f * log1pf(expf(-P.in[16][c])); }
    const float cw0 = P.in[10][(e * 4 + 0) * 512 + chg], cw1 = P.in[10][(e * 4 + 1) * 512 + chg], cw2 = P.in[10][(e * 4 + 2) * 512 + chg], cw3 = P.in[10][(e * 4 + 3) * 512 + chg];
    const float cb = P.in[11][e * 512 + chg];
    LAS float* xs = (LAS float*)(lds + w * LR_WAVE_BYTES);
    LAS float* bs = (LAS float*)(lds + w * LR_WAVE_BYTES + 32 * LR_XS * 4);
    LAS f32x2* cwl = (LAS f32x2*)(lds + LR_CW_OFF);
    float carry = 0.f;
    const bf16_t* xblk = proj + rowbase * PROJ_LD + 1024 + hd * 64;
    const bf16_t* gblk = proj + rowbase * PROJ_LD + 1536 + hd * 64;
    bf16_t* yblk = Y + rowbase * DM + 512 + hd * 64;
    const char* xbase = (const char*)xblk; const char* gbase = (const char*)gblk; char* ybase = (char*)yblk;
    LAS unsigned char* ximg = (LAS unsigned char*)bs;
    u32x4 xq[5];
    {
#pragma unroll
        for (int i = 0; i < 5; ++i) {
            const int c = lane + 64 * i, row = c >> 3;
            const int grow = w * 32 - 3 + row;
            xq[i] = (u32x4){0u, 0u, 0u, 0u};
            if (c < 280 && grow >= 0) xq[i] = *(const u32x4*)(xbase + ((unsigned)grow * (PROJ_LD * 2) + (unsigned)(c & 7) * 16));
        }
#pragma unroll
        for (int i = 0; i < 5; ++i) { const int c = lane + 64 * i; if (c < 280) *(LAS u32x4*)(ximg + (c >> 3) * 128 + (c & 7) * 16) = xq[i]; }
    }
    for (int tile = 0; tile < SEQ / 256; ++tile) {
        const int p0 = tile * 256 + w * 32;
        {
            float xm3 = bf2f(*(const LAS bf16_t*)(ximg + 0 * 128 + lane * 2)), xm2 = bf2f(*(const LAS bf16_t*)(ximg + 1 * 128 + lane * 2)), xm1 = bf2f(*(const LAS bf16_t*)(ximg + 2 * 128 + lane * 2));
#pragma unroll
            for (int pp = 0; pp < 32; ++pp) {
                const float x0 = bf2f(*(const LAS bf16_t*)(ximg + (3 + pp) * 128 + lane * 2));
                xs[pp * LR_XS + lane] = cb + cw0 * xm3 + cw1 * xm2 + cw2 * xm1 + cw3 * x0;
                xm3 = xm2; xm2 = xm1; xm1 = x0;
            }
        }
        f32x16 ga[2], gx[2];
#pragma unroll
        for (int nt = 0; nt < 2; ++nt)
#pragma unroll
            for (int i = 0; i < 16; ++i) { ga[nt][i] = 0.f; gx[nt][i] = 0.f; }
#pragma unroll
        for (int ks = 0; ks < 4; ++ks) {
            const f32x4 a0 = *(const LAS f32x4*)(xs + r * LR_XS + 16 * ks + 8 * hh), a1 = *(const LAS f32x4*)(xs + r * LR_XS + 16 * ks + 8 * hh + 4);
            u32x4 pk; pk.x = cvtpk(a0[0], a0[1]); pk.y = cvtpk(a0[2], a0[3]); pk.z = cvtpk(a1[0], a1[1]); pk.w = cvtpk(a1[2], a1[3]);
            const bf16x8 af = __builtin_bit_cast(bf16x8, pk);
#pragma unroll
            for (int nt = 0; nt < 2; ++nt) { ga[nt] = MFMA32(af, waf[nt][ks], ga[nt]); gx[nt] = MFMA32(af, wxf[nt][ks], gx[nt]); }
        }
#pragma unroll
        for (int nt = 0; nt < 2; ++nt)
#pragma unroll
            for (int i = 0; i < 16; ++i) {
                const int pos = crow(i, hh), ch = 32 * nt + r;
                const float rg = __builtin_amdgcn_rcpf(1.0f + __builtin_amdgcn_exp2f(ga[nt][i] + ba_[nt])), ig = __builtin_amdgcn_rcpf(1.0f + __builtin_amdgcn_exp2f(gx[nt][i] + bx_[nt]));
                const float a = __builtin_amdgcn_exp2f(c8_[nt] * rg);
                const float mult = __builtin_amdgcn_sqrtf(fmaxf(1.0f - a * a, 0.f));
                const float xc = xs[pos * LR_XS + ch];
                xs[pos * LR_XS + ch] = a;
                bs[pos * 64 + ch] = mult * ig * xc;
            }
        float gr[32];
        { const unsigned go = (unsigned)p0 * (PROJ_LD * 2) + lane * 2;
#pragma unroll
          for (int pp = 0; pp < 32; ++pp) gr[pp] = ldbf(gbase + (go + (unsigned)pp * (PROJ_LD * 2))); }
        if (tile + 1 < SEQ / 256) {
#pragma unroll
            for (int i = 0; i < 5; ++i) { const int c = lane + 64 * i;
                if (c < 280) xq[i] = *(const u32x4*)(xbase + ((unsigned)(p0 + 256 - 3 + (c >> 3)) * (PROJ_LD * 2) + (unsigned)(c & 7) * 16)); }
        }
        {
            float hl = 0.f, cp = 1.f;
#pragma unroll 8
            for (int pp = 0; pp < 32; ++pp) {
                const float a = xs[pp * LR_XS + lane], bt = bs[pp * 64 + lane];
                hl = a * hl + bt; cp *= a;
                bs[pp * 64 + lane] = hl; xs[pp * LR_XS + lane] = cp;
            }
            cwl[((tile & 1) * 8 + w) * 64 + lane] = (f32x2){cp, hl};
        }
        WG_BAR();
        {
            float cin = carry, call = carry;
#pragma unroll
            for (int ww = 0; ww < 8; ++ww) { const f32x2 ab = cwl[((tile & 1) * 8 + ww) * 64 + lane]; call = ab[0] * call + ab[1]; if (ww + 1 == w) cin = call; }
            carry = call;
            const unsigned yo = (unsigned)p0 * (DM * 2) + lane * 2;
#pragma unroll
            for (int pp = 0; pp < 32; ++pp) {
                const float hv = bs[pp * 64 + lane] + xs[pp * LR_XS + lane] * cin;
                *(bf16_t*)(ybase + (yo + (unsigned)pp * (DM * 2))) = (bf16_t)(cvtpk(gr[pp] * hv, 0.f) & 0xffffu);
            }
        }
        if (tile + 1 < SEQ / 256) {
#pragma unroll
            for (int i = 0; i < 5; ++i) { const int c = lane + 64 * i; if (c < 280) *(LAS u32x4*)(ximg + (c >> 3) * 128 + (c & 7) * 16) = xq[i]; }
        }
    }
    WG_BAR();
}

constexpr int SG_RS = 288, SG_IMG = 128 * SG_RS, SG_STAT = SG_IMG, SG_OUT = SG_IMG + 1024, SG_OS = 132;
typedef short v4i16_t __attribute__((ext_vector_type(4)));
__device__ __forceinline__ v4i16_t lds_tr16(const LAS unsigned char* p) { return __builtin_amdgcn_ds_read_tr16_b64_v4i16((LAS v4i16_t*)p); }
__device__ __forceinline__ void sgu_unit(const Params& P, int o, int unit, LAS unsigned char* lds) {
    int tid_ = threadIdx.x; asm volatile("" : "+v"(tid_));
    const int tid = tid_, lane = tid & 63, w = __builtin_amdgcn_readfirstlane(tid >> 6), r = lane & 31, hh = lane >> 5;
    const bf16_t* Z = (const bf16_t*)(P.ws + WS_H); bf16_t* Y = (bf16_t*)(P.ws + WS_Y);
    const int g = unit & 7; const size_t row0 = (size_t)(unit >> 3) * 128;
    const int c16 = tid & 15, qt = tid >> 4;
    LAS f32x2* stat = (LAS f32x2*)(lds + SG_STAT);
    if (tid < 128) {
        const f32x4* lp = (const f32x4*)((const float*)(P.ws + WS_LNS) + (row0 + tid) * 32);
        float sum = 0.f, sq = 0.f;
#pragma unroll
        for (int i = 0; i < 8; ++i) { const f32x4 t = lp[i]; sum += t[0] + t[2]; sq += t[1] + t[3]; }
        const float mean = sum * (1.0f / 1024.0f), var = sq * (1.0f / 1024.0f) - mean * mean;
        stat[tid] = (f32x2){mean, rsqrtf(var + RMS_EPS)};
    }
    u32x4 zraw[4], uraw[4];
#pragma unroll
    for (int i = 0; i < 4; ++i) { const bf16_t* zp = Z + (row0 + qt + 32 * i) * PROJ_LD + g * 128 + c16 * 8; zraw[i] = *(const u32x4*)(zp + 1024); uraw[i] = *(const u32x4*)zp; }
    float lg[8], lb[8];
    { const float* gp = P.in[19] + o * 1024 + g * 128 + c16 * 8; const float* bp = P.in[20] + o * 1024 + g * 128 + c16 * 8;
      const f32x4 g0 = *(const f32x4*)gp, g1 = *(const f32x4*)(gp + 4), b0 = *(const f32x4*)bp, b1 = *(const f32x4*)(bp + 4);
#pragma unroll
      for (int e2 = 0; e2 < 4; ++e2) { lg[e2] = g0[e2]; lg[4 + e2] = g1[e2]; lb[e2] = b0[e2]; lb[4 + e2] = b1[e2]; } }
    WG_BAR();
#pragma unroll
    for (int i = 0; i < 4; ++i) {
        const int q = qt + 32 * i; const f32x2 st = stat[q]; const u32x4 raw = zraw[i];
        float v[8];
        v[0] = __uint_as_float(raw.x << 16); v[1] = __uint_as_float(raw.x & 0xffff0000u); v[2] = __uint_as_float(raw.y << 16); v[3] = __uint_as_float(raw.y & 0xffff0000u);
        v[4] = __uint_as_float(raw.z << 16); v[5] = __uint_as_float(raw.z & 0xffff0000u); v[6] = __uint_as_float(raw.w << 16); v[7] = __uint_as_float(raw.w & 0xffff0000u);
#pragma unroll
        for (int e2 = 0; e2 < 8; ++e2) v[e2] = (v[e2] - st[0]) * st[1] * lg[e2] + lb[e2];
        u32x4 pk; pk.x = cvtpk(v[0], v[1]); pk.y = cvtpk(v[2], v[3]); pk.z = cvtpk(v[4], v[5]); pk.w = cvtpk(v[6], v[7]);
        *(LAS u32x4*)(lds + q * SG_RS + c16 * 16) = pk;
    }
    WG_BAR();
    const int pb = w >> 1, cb0 = (w & 1) * 2;
    f32x16 acc[2];
#pragma unroll
    for (int cc = 0; cc < 2; ++cc)
#pragma unroll
        for (int i = 0; i < 16; ++i) acc[cc][i] = 0.f;
    const bf16_t* wsm = (const bf16_t*)(P.ws + WS_SMALL + SM_WS) + ((size_t)(o * 8 + g) * 128 + 32 * pb + r) * 128 + 8 * hh;
    const int trb = (8 * hh + ((lane & 15) >> 2)) * SG_RS + (16 * ((lane >> 4) & 1) + 4 * (lane & 3)) * 2;
#pragma unroll
    for (int ks = 0; ks < 8; ++ks) {
        if (pb >= 2 || ks < 4) {
            const bf16x8 af = *(const bf16x8*)(wsm + 16 * ks);
#pragma unroll
            for (int cc = 0; cc < 2; ++cc) {
                const LAS unsigned char* tp = lds + trb + 16 * ks * SG_RS + 32 * (cb0 + cc) * 2;
                const v4i16_t lo = lds_tr16(tp), hi = lds_tr16(tp + 4 * SG_RS);
                const bf16x8 bfr = (bf16x8){lo[0], lo[1], lo[2], lo[3], hi[0], hi[1], hi[2], hi[3]};
                acc[cc] = MFMA32(af, bfr, acc[cc]);
            }
        }
    }
    const float* bsp = P.in[22] + (o * 8 + g) * 128 + 32 * pb;
    LAS float* oimg = (LAS float*)(lds + SG_OUT);
#pragma unroll
    for (int cc = 0; cc < 2; ++cc)
#pragma unroll
        for (int i = 0; i < 16; ++i) { const int pl = crow(i, hh); oimg[(32 * pb + pl) * SG_OS + 32 * (cb0 + cc) + r] = acc[cc][i] + bsp[pl]; }
    WG_BAR();
#pragma unroll
    for (int i = 0; i < 4; ++i) {
        const int p = qt + 32 * i; const u32x4 raw = uraw[i];
        const f32x4 m0 = *(const LAS f32x4*)(oimg + p * SG_OS + c16 * 8), m1 = *(const LAS f32x4*)(oimg + p * SG_OS + c16 * 8 + 4);
        u32x4 pk;
        pk.x = cvtpk(__uint_as_float(raw.x << 16) * m0[0], __uint_as_float(raw.x & 0xffff0000u) * m0[1]); pk.y = cvtpk(__uint_as_float(raw.y << 16) * m0[2], __uint_as_float(raw.y & 0xffff0000u) * m0[3]);
        pk.z = cvtpk(__uint_as_float(raw.z << 16) * m1[0], __uint_as_float(raw.z & 0xffff0000u) * m1[1]); pk.w = cvtpk(__uint_as_float(raw.w << 16) * m1[2], __uint_as_float(raw.w & 0xffff0000u) * m1[3]);
        *(u32x4*)(Y + (row0 + p) * DM + g * 128 + c16 * 8) = pk;
    }
}

__device__ __forceinline__ void final_norm_phase(const Params& P) {
    int tid_ = threadIdx.x; asm volatile("" : "+v"(tid_));
    const int tid = tid_, lane = tid & 63, wave = tid >> 6;
    const int gw = blockIdx.x * 8 + wave, NGW = gridDim.x * 8;
    const bf16_t* xb = (const bf16_t*)(P.ws + WS_XB);
    const f32x4* gp = (const f32x4*)P.in[3] + lane;
    f32x4 gv[4];
#pragma unroll
    for (int j = 0; j < 4; ++j) gv[j] = gp[64 * j];
    for (int m = gw; m < MTOK; m += 2 * NGW) {
        const int m1 = (m + NGW < MTOK) ? m + NGW : m;
        const u32x2* xr0 = (const u32x2*)(xb + (size_t)m * DM) + lane;
        const u32x2* xr1 = (const u32x2*)(xb + (size_t)m1 * DM) + lane;
        u32x2 t0[4], t1[4];
#pragma unroll
        for (int j = 0; j < 4; ++j) { t0[j] = xr0[64 * j]; t1[j] = xr1[64 * j]; }
        f32x4 v0[4], v1[4]; float s0 = 0.f, s1 = 0.f;
#pragma unroll
        for (int j = 0; j < 4; ++j) {
            v0[j][0] = __uint_as_float(t0[j].x << 16); v0[j][1] = __uint_as_float(t0[j].x & 0xffff0000u); v0[j][2] = __uint_as_float(t0[j].y << 16); v0[j][3] = __uint_as_float(t0[j].y & 0xffff0000u);
            v1[j][0] = __uint_as_float(t1[j].x << 16); v1[j][1] = __uint_as_float(t1[j].x & 0xffff0000u); v1[j][2] = __uint_as_float(t1[j].y << 16); v1[j][3] = __uint_as_float(t1[j].y & 0xffff0000u);
            s0 += (v0[j][0] * v0[j][0] + v0[j][1] * v0[j][1]) + (v0[j][2] * v0[j][2] + v0[j][3] * v0[j][3]);
            s1 += (v1[j][0] * v1[j][0] + v1[j][1] * v1[j][1]) + (v1[j][2] * v1[j][2] + v1[j][3] * v1[j][3]); }
        const float rs0 = rsqrtf(wave_sum(s0) * (1.0f / 1024.0f) + RMS_EPS), rs1 = rsqrtf(wave_sum(s1) * (1.0f / 1024.0f) + RMS_EPS);
        f32x4* o0 = (f32x4*)(P.out + (size_t)m * DM) + lane;
#pragma unroll
        for (int j = 0; j < 4; ++j) o0[64 * j] = v0[j] * rs0 * gv[j];
        if (m1 != m) {
            f32x4* o1 = (f32x4*)(P.out + (size_t)m1 * DM) + lane;
#pragma unroll
            for (int j = 0; j < 4; ++j) o1[64 * j] = v1[j] * rs1 * gv[j];
        }
    }
}

constexpr int LDS_RSL = 131072;
template <bool COLS> __device__ __forceinline__ void fill_rs(LAS float* rsl, const pg8::StaticOrder& S, const float* part) {
    int tid_ = threadIdx.x; asm volatile("" : "+v"(tid_));
    LAS int* ul = (LAS int*)(rsl + 14 * 256);
    if (tid_ < 16) { pg8::Unit u; int v = -1; if (tid_ < 14 && S.next(tid_, u)) v = COLS ? u.pn : u.pm; ul[tid_] = v; }
    __syncthreads();
    for (int idx = tid_; idx < 14 * 256; idx += 512) {
        const int p = ul[idx >> 8]; if (p < 0) break;
        rsl[idx] = pg8::rs_from_part(part, p * 256 + (idx & 255));
    }
    __syncthreads();
}

__global__ void __launch_bounds__(512, 2) fwd_kernel(Params P) {
    extern __shared__ __attribute__((aligned(16))) unsigned char lds_raw[];
    LAS unsigned char* lds = (LAS unsigned char*)lds_raw;
    cg::grid_group grid = cg::this_grid();
    unsigned char* ws = P.ws;
    const int G = gridDim.x, bx = blockIdx.x;
    bf16_t* XB = (bf16_t*)(ws + WS_XB); bf16_t* YB = (bf16_t*)(ws + WS_Y); bf16_t* HB = (bf16_t*)(ws + WS_H); bf16_t* VT = (bf16_t*)(ws + WS_VT);
    float* part = (float*)(ws + WS_PART); pg8::f32x2v* lns = (pg8::f32x2v*)(ws + WS_LNS);

    LAS unsigned* misc = (LAS unsigned*)(lds + LDS_CTL);
    if (threadIdx.x < 16) misc[threadIdx.x] = 0u;
    __syncthreads();
    prologue_phase(P, lds);
    grid.sync();
    const XcdBarrier xbar = xcd_barrier_post((unsigned*)(ws + WS_CTL) + CW_BAR, (volatile LAS unsigned*)(misc + 8));
#define GSYNC() xcd_barrier(xbar)

    for (int l = 0; l < 4; ++l) {
        const int e = l >> 1;
        if ((l & 1) == 0) {
            { const bf16_t* Wt = (const bf16_t*)(ws + WS_WIN) + (size_t)e * 2560 * 1024;
              { pg8::Gemm g{XB, Wt, MTOK, 2048, 1024}; pg8::StaticOrder S; S.init(MTOK, 2048, G, bx);
                fill_rs<false>((LAS float*)(lds + LDS_RSL), S, part);
                pg8::EpiScaleAct<0, false, 6> E{HB, PROJ_LD, (const LAS float*)(lds + LDS_RSL), lns};
                pg8::gemm_phase<pg8::EpiScaleAct<0, false, 6>, pg8::StaticOrder, true, true>(lds, g, S, E); }
              { pg8::Gemm g{Wt + (size_t)2048 * 1024, XB, 512, MTOK, 1024}; pg8::StaticOrder S; S.init(512, MTOK, G, bx);
                fill_rs<true>((LAS float*)(lds + LDS_RSL), S, part);
                pg8::EpiVT E{VT, MTOK, (const LAS float*)(lds + LDS_RSL)};
                pg8::gemm_phase<pg8::EpiVT, pg8::StaticOrder, true, true>(lds, g, S, E); } }
            GSYNC();
            { const float lam = ((const float*)(ws + WS_SMALL + SM_LAM))[e];
              const float lam_init = (e == 0) ? 0.2f : (0.8f - 0.6f * 0.54881163609f);
              LAS unsigned* bc = (LAS unsigned*)(lds + LDS_CTL);
              unsigned* qbase = (unsigned*)(ws + WS_CTL) + e * 8;
              for (int kq = 0; kq < 8; ++kq) {
                  const int xq = (bx + kq) & 7;
                  if (kq == 1) {
                      int t_ = threadIdx.x; asm volatile("" : "+v"(t_));
                      if (t_ >= 1 && t_ < 8) bc[t_] = __hip_atomic_load(qbase + ((bx + t_) & 7), __ATOMIC_RELAXED, __HIP_MEMORY_SCOPE_AGENT);
                      WG_BAR();
                  }
                  if (kq >= 1 && bc[kq] >= (unsigned)(8 + 128)) continue;
                  if (threadIdx.x == 0) bc[0] = atomicAdd(qbase + xq, 1u);
                  for (;;) {
                      WG_BAR();
                      const unsigned idx = bc[0];
                      WG_BAR();
                      if (idx >= (unsigned)(8 + 128)) break;
                      unsigned pre = 0u;
                      if (idx < 8u) { lru_unit(P, e, xq, (int)idx, lds); if (threadIdx.x == 0) pre = atomicAdd(qbase + xq, 1u); }
                      else { const int a = (int)idx - 8; const int qb = 31 - (a >> 2), h = a & 3;
                             attn_unit(HB, VT, YB, P.in[9] + e * 128, lam, 1.0f - lam_init, xq, h, qb, qbase + xq, pre, lds); }
                      if (threadIdx.x == 0) bc[0] = pre;
                  }
              } }
            GSYNC();
        } else {
            { const bf16_t* Wt = (const bf16_t*)(ws + WS_CIN) + (size_t)e * 2048 * 1024;
              pg8::Gemm g{XB, Wt, MTOK, 2048, 1024}; pg8::StaticOrder S; S.init(MTOK, 2048, G, bx);
              fill_rs<false>((LAS float*)(lds + LDS_RSL), S, part);
              pg8::EpiScaleAct<1, true> E{HB, PROJ_LD, (const LAS float*)(lds + LDS_RSL), lns};
              pg8::gemm_phase<pg8::EpiScaleAct<1, true>, pg8::StaticOrder, true, true>(lds, g, S, E); }
            GSYNC();
            for (int u = bx; u < 2048; u += G) sgu_unit(P, e, u, lds);
            GSYNC();
        }
        { const bf16_t* Wt = (l & 1) ? (const bf16_t*)(ws + WS_COUT) + (size_t)e * 1024 * 1024 : (const bf16_t*)(ws + WS_WOUT) + (size_t)e * 1024 * 1024;
          pg8::Gemm g{YB, Wt, MTOK, 1024, 1024}; pg8::StaticOrder S; S.init(MTOK, 1024, G, bx);
          pg8::EpiResid E{XB, part};
          pg8::gemm_phase<pg8::EpiResid, pg8::StaticOrder, true, true>(lds, g, S, E); }
        GSYNC();
        { const bf16_t* Wt = (const bf16_t*)(ws + WS_W1) + (size_t)l * 4096 * 1024;
          pg8::Gemm g{XB, Wt, MTOK, 4096, 1024}; pg8::StaticOrder S; S.init(MTOK, 4096, G, bx);
          fill_rs<false>((LAS float*)(lds + LDS_RSL), S, part);
          pg8::EpiScaleAct<2, false> E{HB, DFF, (const LAS float*)(lds + LDS_RSL), lns};
          pg8::gemm_phase<pg8::EpiScaleAct<2, false>, pg8::StaticOrder, true, true>(lds, g, S, E); }
        GSYNC();
        { const bf16_t* Wt = (const bf16_t*)(ws + WS_W2) + (size_t)l * 1024 * 4096;
          pg8::Gemm g{HB, Wt, MTOK, 1024, 4096}; pg8::StaticOrder S; S.init(MTOK, 1024, G, bx);
          pg8::EpiResid E{XB, part};
          pg8::gemm_phase<pg8::EpiResid, pg8::StaticOrder, true, true>(lds, g, S, E); }
        GSYNC();
    }
    final_norm_phase(P);
}

extern "C" void kernel_launch(void* const* d_in, const int* in_sizes, int n_in, void* d_out, int out_size, void* d_ws, size_t ws_size, hipStream_t stream) {
    static int grid = 0;
    if (grid == 0) {
        if (n_in != 26 || in_sizes[0] != MTOK * DM || out_size != MTOK * DM || ws_size < WS_END) {
            fprintf(stderr, "kernel_launch: unexpected shapes (n_in %d, in0 %d, out %d, ws %zu; need ws >= %zu); nothing launched\n", n_in, n_in > 0 ? in_sizes[0] : -1, out_size, ws_size, (size_t)WS_END);
            grid = -1; return; }
        int dev = 0, cus = 0, per_cu = 0;
        if (hipGetDevice(&dev) != hipSuccess || hipDeviceGetAttribute(&cus, hipDeviceAttributeMultiprocessorCount, dev) != hipSuccess) { fprintf(stderr, "kernel_launch: device query failed\n"); grid = -1; return; }
        if (hipFuncSetAttribute((const void*)fwd_kernel, hipFuncAttributeMaxDynamicSharedMemorySize, LDS_BYTES) != hipSuccess) { fprintf(stderr, "kernel_launch: hipFuncSetAttribute failed\n"); grid = -1; return; }
        if (hipOccupancyMaxActiveBlocksPerMultiprocessor(&per_cu, (const void*)fwd_kernel, 512, LDS_BYTES) != hipSuccess || per_cu < 1) { fprintf(stderr, "kernel_launch: occupancy query gave %d\n", per_cu); per_cu = 1; }
        (void)hipGetLastError();
        grid = cus * per_cu;
    }
    if (grid < 0) return;
    Params p{};
    for (int i = 0; i < 26; ++i) p.in[i] = (const float*)d_in[i];
    p.out = (float*)d_out; p.ws = (unsigned char*)d_ws;
    void* args[] = {&p};
    hipError_t err = hipLaunchCooperativeKernel((const void*)fwd_kernel, dim3(grid), dim3(512), args, LDS_BYTES, stream);
    if (err != hipSuccess) fprintf(stderr, "kernel_launch: cooperative launch failed: %s (grid %d)\n", hipGetErrorString(err), grid);
}
```

```cpp
#include <hip/hip_runtime.h>
#include <hip/hip_cooperative_groups.h>
#include <cstdio>
#include <cstdint>
namespace cg = cooperative_groups;
namespace pg8 {
#define PG8_LAS __attribute__((address_space(3)))
typedef unsigned short bf16_t;
typedef short bf16x8 __attribute__((ext_vector_type(8)));
typedef float f32x4 __attribute__((ext_vector_type(4)));
typedef unsigned u32x4 __attribute__((ext_vector_type(4)));
constexpr int BM = 256, BK = 64, HALF = 128, HTB = HALF * BK * 2  , STAGE_BYTES = 8 * HTB, NXCD = 8, WGM = 8;

__host__ __device__ __forceinline__ int lds_byte(int r, int c) { const int st = (r >> 4) * 2 + (c >> 5), rr = r & 15, cc = c & 31, ob = rr * 64 + cc * 2; return st * 1024 + (ob ^ (((ob >> 9) & 1) << 5)); }
__host__ __device__ __forceinline__ void stage_rc(int b, int& R, int& C) { const int st = b / 1024, sb = b % 1024, swz = sb ^ (((sb >> 9) & 1) << 5); R = (st >> 1) * 16 + swz / 64; C = (st & 1) * 32 + (swz % 64) / 2; }
__host__ __device__ __forceinline__ int perm32(int rho) { const int n = rho >> 4, i = rho & 15; return 8 * (i >> 2) + 4 * n + (i & 3); }

struct Unit { int pm, pn, ui; };
struct Gemm { const bf16_t* A; const bf16_t* Bt; int M, N, K; };

struct StaticOrder {
    int nM, nN, nwg, G, c;
    __host__ __device__ void init(int M, int N, int G_, int c_) { nM = M / BM; nN = N / BM; nwg = nM * nN; G = G_; c = c_; }
    __host__ __device__ bool next(int i, Unit& u) const {
        const long L = (long)i * G + c; if (L >= nwg) return false;
        int wgid = (int)L; { const int q = nwg / NXCD, r = nwg % NXCD, xcd = wgid % NXCD, off = wgid / NXCD; wgid = (xcd < r ? xcd * (q + 1) : r * (q + 1) + (xcd - r) * q) + off; }
        const int nig = WGM * nN, gid = wgid / nig, fm = gid * WGM, gsz = (nM - fm) < WGM ? (nM - fm) : WGM;
        u.pm = fm + ((wgid % nig) % gsz); u.pn = (wgid % nig) / gsz; u.ui = i; return true;
    }
    __device__ __forceinline__ void a_ready(const Unit&) const {}
    __device__ __forceinline__ void done(const Unit&) const {}
};

__device__ __forceinline__ unsigned cvt_pk_bf16(float lo, float hi) { unsigned r; asm volatile("v_cvt_pk_bf16_f32 %0, %1, %2" : "=v"(r) : "v"(lo), "v"(hi)); return r; }
typedef float f32x2v __attribute__((ext_vector_type(2)));
typedef unsigned u32x2v __attribute__((ext_vector_type(2)));
typedef __bf16 bf16x2_t __attribute__((ext_vector_type(2)));
__device__ __forceinline__ unsigned cvtpk(float lo, float hi) { f32x2v v = {lo, hi}; bf16x2_t b = __builtin_convertvector(v, bf16x2_t); return __builtin_bit_cast(unsigned, b); }
constexpr float RMS_EPS = 1e-6f;
__device__ __forceinline__ float gelu_tanh(float x) {
    const float u = x * (1.0f + 0.044715f * x * x);
    const float e = __builtin_amdgcn_exp2f(-2.302208198f * u);
    return x * __builtin_amdgcn_rcpf(1.0f + e);
}
__device__ __forceinline__ float rs_from_part(const float* part, int row) {
    const f32x4* pp = (const f32x4*)(part + (size_t)row * 16);
    const f32x4 a = pp[0], b = pp[1], c = pp[2], d = pp[3];
    const float s = ((a[0] + a[1]) + (a[2] + a[3])) + ((b[0] + b[1]) + (b[2] + b[3])) + ((c[0] + c[1]) + (c[2] + c[3])) + ((d[0] + d[1]) + (d[2] + d[3]));
    return rsqrtf(s * (1.0f / 1024.0f) + RMS_EPS);
}
template <int ACT, bool STATS, int GELU_PN = 99> struct EpiScaleAct {
    static constexpr bool PERM = true, AFTER_DRAIN = false;
    bf16_t* O; int ldc; const PG8_LAS float* rsl; f32x2v* lns;
    __device__ __forceinline__ void operator()(const f32x4 (&acc)[2][2][4][2], const Unit& u, int wr, int wc, int fr, int fq) const {
        const int row0 = u.pm * BM + wr * 64 + fr, col0 = u.pn * BM + wc * 32 + 8 * fq;
        float rs8[2][4];
#pragma unroll
        for (int ai = 0; ai < 2; ++ai)
#pragma unroll
            for (int m = 0; m < 4; ++m) rs8[ai][m] = rsl[u.ui * BM + wr * 64 + fr + ai * HALF + m * 16];
#pragma unroll
        for (int ai = 0; ai < 2; ++ai)
#pragma unroll
            for (int m = 0; m < 4; ++m) {
                const int row = row0 + ai * HALF + m * 16;
                const float rs = rs8[ai][m];
                bf16_t* rowp = O + (size_t)row * ldc + col0;
                float ssum = 0.f, ssq = 0.f;
#pragma unroll
                for (int bj = 0; bj < 2; ++bj) {
                    f32x4 v0 = acc[ai][bj][m][0] * rs, v1 = acc[ai][bj][m][1] * rs;
                    if (ACT == 1 || (GELU_PN < 99 && u.pn >= GELU_PN)) {
#pragma unroll
                        for (int e = 0; e < 4; ++e) { v0[e] = gelu_tanh(v0[e]); v1[e] = gelu_tanh(v1[e]); }
                    }
                    if (ACT == 2) {
#pragma unroll
                        for (int e = 0; e < 4; ++e) { const float a = fmaxf(v0[e], 0.f), b = fmaxf(v1[e], 0.f); v0[e] = a * a; v1[e] = b * b; }
                    }
                    if (STATS) {
#pragma unroll
                        for (int e = 0; e < 4; ++e) { ssum += v0[e] + v1[e]; ssq += v0[e] * v0[e] + v1[e] * v1[e]; }
                    }
                    u32x4 w; w.x = cvtpk(v0[0], v0[1]); w.y = cvtpk(v0[2], v0[3]); w.z = cvtpk(v1[0], v1[1]); w.w = cvtpk(v1[2], v1[3]);
                    if (ACT == 2) __builtin_nontemporal_store(w, (u32x4*)(rowp + bj * HALF));
                    else *(u32x4*)(rowp + bj * HALF) = w;
                }
                if (STATS) {
                    ssum += __shfl_xor(ssum, 16); ssum += __shfl_xor(ssum, 32);
                    ssq += __shfl_xor(ssq, 16); ssq += __shfl_xor(ssq, 32);
                    if (u.pn >= 4 && fq == 0) lns[(size_t)row * 16 + (u.pn - 4) * 4 + wc] = (f32x2v){ssum, ssq};
                }
            }
    }
};
struct EpiVT {
    static constexpr bool PERM = true, AFTER_DRAIN = false;
    bf16_t* O; int ldc; const PG8_LAS float* rsl;
    __device__ __forceinline__ void operator()(const f32x4 (&acc)[2][2][4][2], const Unit& u, int wr, int wc, int fr, int fq) const {
        const int row0 = u.pm * BM + wr * 64 + fr, col0 = u.pn * BM + wc * 32 + 8 * fq;
        f32x4 rsv[2][2];
#pragma unroll
        for (int bj = 0; bj < 2; ++bj)
#pragma unroll
            for (int n = 0; n < 2; ++n) rsv[bj][n] = *(const PG8_LAS f32x4*)(rsl + u.ui * BM + wc * 32 + 8 * fq + bj * HALF + 4 * n);
#pragma unroll
        for (int ai = 0; ai < 2; ++ai)
#pragma unroll
            for (int m = 0; m < 4; ++m) {
                const int row = row0 + ai * HALF + m * 16;
#pragma unroll
                for (int bj = 0; bj < 2; ++bj) {
                    const int tok = col0 + bj * HALF;
                    bf16_t* dst = O + ((((size_t)((tok >> 12) * 4 + (row >> 7)) * 64 + ((tok >> 6) & 63)) * 128 + (row & 127)) * 64 + (tok & 63));
                    const f32x4 v0 = acc[ai][bj][m][0] * rsv[bj][0], v1 = acc[ai][bj][m][1] * rsv[bj][1];
                    u32x4 w; w.x = cvtpk(v0[0], v0[1]); w.y = cvtpk(v0[2], v0[3]); w.z = cvtpk(v1[0], v1[1]); w.w = cvtpk(v1[2], v1[3]);
                    *(u32x4*)dst = w;
                }
            }
    }
};
struct EpiResid {
    static constexpr bool PERM = true, AFTER_DRAIN = false;
    bf16_t* xb; float* part;
    __device__ __forceinline__ void operator()(const f32x4 (&acc)[2][2][4][2], const Unit& u, int wr, int wc, int fr, int fq) const {
        const int row0 = u.pm * BM + wr * 64 + fr, col0 = u.pn * BM + wc * 32 + 8 * fq;
#pragma unroll
        for (int ai = 0; ai < 2; ++ai) {
            u32x4 old[4][2];
#pragma unroll
            for (int m = 0; m < 4; ++m)
#pragma unroll
                for (int bj = 0; bj < 2; ++bj) old[m][bj] = *(const u32x4*)(xb + (size_t)(row0 + ai * HALF + m * 16) * 1024 + col0 + bj * HALF);
            asm volatile("" ::: "memory");
#pragma unroll
            for (int m = 0; m < 4; ++m) {
                const int row = row0 + ai * HALF + m * 16;
                bf16_t* xp = xb + (size_t)row * 1024 + col0;
                float ss = 0.f;
#pragma unroll
                for (int bj = 0; bj < 2; ++bj) {
                    const u32x4 ov = old[m][bj];
                    f32x4 o0 = acc[ai][bj][m][0], o1 = acc[ai][bj][m][1];
                    o0[0] += __uint_as_float(ov.x << 16); o0[1] += __uint_as_float(ov.x & 0xffff0000u); o0[2] += __uint_as_float(ov.y << 16); o0[3] += __uint_as_float(ov.y & 0xffff0000u);
                    o1[0] += __uint_as_float(ov.z << 16); o1[1] += __uint_as_float(ov.z & 0xffff0000u); o1[2] += __uint_as_float(ov.w << 16); o1[3] += __uint_as_float(ov.w & 0xffff0000u);
                    ss += ((o0[0] * o0[0] + o0[1] * o0[1]) + (o0[2] * o0[2] + o0[3] * o0[3])) + ((o1[0] * o1[0] + o1[1] * o1[1]) + (o1[2] * o1[2] + o1[3] * o1[3]));
                    u32x4 w; w.x = cvtpk(o0[0], o0[1]); w.y = cvtpk(o0[2], o0[3]); w.z = cvtpk(o1[0], o1[1]); w.w = cvtpk(o1[2], o1[3]);
                    *(u32x4*)(xp + bj * HALF) = w;
                }
                ss += __shfl_xor(ss, 16); ss += __shfl_xor(ss, 32);
                if (fq == 0) part[(size_t)row * 16 + u.pn * 4 + wc] = ss;
            }
            asm volatile("" ::: "memory");
        }
    }
};
template <class Epi, class Sched, bool ALIGN_EPI = false, bool SP2 = false>
__device__ __forceinline__ void gemm_phase(PG8_LAS unsigned char* lds, const Gemm g, const Sched& S, const Epi& E) {
    int tid_ = threadIdx.x; asm volatile("" : "+v"(tid_));
    const int tid = tid_, wid = __builtin_amdgcn_readfirstlane(tid >> 6), lane = tid & 63, wr = wid >> 2, wc = wid & 3, fr = lane & 15, fq = lane >> 4;
    const int K = g.K, nt = K / BK;
    unsigned voffA[2], voffB[2];
#pragma unroll
    for (int i = 0; i < 2; ++i) { int R, C; stage_rc(tid * 16 + i * 8192, R, C); const int Rb = Epi::PERM ? ((R & ~31) + perm32(R & 31)) : R;
        voffA[i] = (unsigned)(R * K + C) * 2u; voffB[i] = (unsigned)(Rb * K + C) * 2u; }
    const size_t kstep = (size_t)(BK * 2);
    const size_t hstep = (size_t)HALF * K * 2;
    const size_t tstep = 2 * hstep;
    const unsigned ldsw = (unsigned)wid * 1024u;
    const int aoff = lds_byte(wr * 64 + fr, fq * 8), boff = lds_byte(wc * 32 + fr, fq * 8);
#define PG8_SA(b, h) (((b) * 2 + (h)) * HTB)
#define PG8_SB(b, h) ((4 + (b) * 2 + (h)) * HTB)
#define PG8_STAGE(bufoff, gbase, voff) do { _Pragma("unroll") for (int _i = 0; _i < 2; ++_i) \
        __builtin_amdgcn_global_load_lds((const unsigned*)((const char*)(gbase) + (voff)[_i]), (PG8_LAS unsigned*)(lds + (bufoff) + ldsw + _i * 8192), 16, 0, 0); } while (0)
#define PG8_LDA(dst, b, h) do { _Pragma("unroll") for (int m = 0; m < 4; ++m) _Pragma("unroll") for (int k = 0; k < 2; ++k) dst[m][k] = *(const PG8_LAS bf16x8*)(lds + PG8_SA(b, h) + aoff + m * 2048 + k * 1024); } while (0)
#define PG8_LDB(dst, b, h) do { _Pragma("unroll") for (int n = 0; n < 2; ++n) _Pragma("unroll") for (int k = 0; k < 2; ++k) dst[n][k] = *(const PG8_LAS bf16x8*)(lds + PG8_SB(b, h) + boff + n * 2048 + k * 1024); } while (0)
#define PG8_MMA(ai, bj, At, Bt) do { __builtin_amdgcn_s_setprio(1); _Pragma("unroll") for (int m = 0; m < 4; ++m) _Pragma("unroll") for (int n = 0; n < 2; ++n) _Pragma("unroll") for (int k = 0; k < 2; ++k) \
        acc[ai][bj][m][n] = __builtin_amdgcn_mfma_f32_16x16x32_bf16(Bt[n][k], At[m][k], acc[ai][bj][m][n], 0, 0, 0); __builtin_amdgcn_s_setprio(0); } while (0)
#define PG8_WAIT_V(n) asm volatile("s_waitcnt vmcnt(" #n ")" ::: "memory")
#define PG8_WAIT_L(n) asm volatile("s_waitcnt lgkmcnt(" #n ")" ::: "memory")
#define PG8_BAR __builtin_amdgcn_s_barrier()
#define PG8_SCHED __builtin_amdgcn_sched_barrier(0)
    Unit cur, nxt; int ui = 0;
    if (!S.next(0, cur)) return;
    f32x4 acc[2][2][4][2];
#pragma unroll
    for (int a = 0; a < 2; ++a)
#pragma unroll
        for (int b = 0; b < 2; ++b)
#pragma unroll
            for (int m = 0; m < 4; ++m)
#pragma unroll
                for (int n = 0; n < 2; ++n) acc[a][b][m][n] = (f32x4){0.f, 0.f, 0.f, 0.f};
    bf16x8 At[4][2], B0[2][2], B1[2][2];
    const char* cA = (const char*)g.A + (size_t)cur.pm * tstep; const char* cB = (const char*)g.Bt + (size_t)cur.pn * tstep;
    S.a_ready(cur);
    if constexpr (SP2) {
        PG8_STAGE(PG8_SB(0, 0), cB, voffB); PG8_STAGE(PG8_SB(0, 1), cB + hstep, voffB); PG8_STAGE(PG8_SA(0, 0), cA, voffA); PG8_STAGE(PG8_SA(0, 1), cA + hstep, voffA);
        if (wr == 1) PG8_BAR;
        PG8_WAIT_V(2); PG8_BAR;
        PG8_STAGE(PG8_SB(1, 0), cB + kstep, voffB); PG8_STAGE(PG8_SA(1, 0), cA + kstep, voffA); PG8_STAGE(PG8_SB(1, 1), cB + hstep + kstep, voffB);
        PG8_WAIT_V(6); PG8_BAR;
    } else {
        PG8_STAGE(PG8_SB(0, 0), cB, voffB); PG8_STAGE(PG8_SA(0, 0), cA, voffA); PG8_STAGE(PG8_SB(0, 1), cB + hstep, voffB); PG8_STAGE(PG8_SA(0, 1), cA + hstep, voffA);
        if (wr == 1) PG8_BAR;
        PG8_WAIT_V(4); PG8_BAR;
        PG8_STAGE(PG8_SB(1, 0), cB + kstep, voffB); PG8_STAGE(PG8_SA(1, 0), cA + kstep, voffA); PG8_STAGE(PG8_SB(1, 1), cB + hstep + kstep, voffB);
        PG8_WAIT_V(6); PG8_BAR;
    }
    for (;;) {
        const bool has_next = S.next(ui + 1, nxt);
        const char* nA = has_next ? (const char*)g.A + (size_t)nxt.pm * tstep : cA; const char* nB = has_next ? (const char*)g.Bt + (size_t)nxt.pn * tstep : cB;
        for (int t = 0; t < nt; t += 2) {
            const bool last = (t == nt - 2);
            const char* a1 = cA + (size_t)(t + 1) * kstep;
            const char* a2 = last ? nA : cA + (size_t)(t + 2) * kstep; const char* b2 = last ? nB : cB + (size_t)(t + 2) * kstep;
            const char* a3 = a2 + kstep; const char* b3 = b2 + kstep;
            if (last && has_next) S.a_ready(nxt);
            if constexpr (SP2) {
            PG8_LDB(B0, 0, 0); PG8_LDB(B1, 0, 1); PG8_SCHED; PG8_LDA(At, 0, 0); PG8_STAGE(PG8_SA(1, 1), a1 + hstep, voffA);
            PG8_WAIT_V(8); PG8_WAIT_L(0); PG8_BAR; PG8_MMA(0, 0, At, B0); PG8_MMA(0, 1, At, B1); PG8_BAR; PG8_SCHED;
            PG8_LDA(At, 0, 1); PG8_STAGE(PG8_SB(0, 0), b2, voffB); PG8_STAGE(PG8_SB(0, 1), b2 + hstep, voffB); PG8_STAGE(PG8_SA(0, 0), a2, voffA);
            PG8_WAIT_V(8); PG8_WAIT_L(0); PG8_BAR; PG8_MMA(1, 0, At, B0); PG8_MMA(1, 1, At, B1); PG8_BAR; PG8_SCHED;
            PG8_LDB(B0, 1, 0); PG8_LDB(B1, 1, 1); PG8_SCHED; PG8_LDA(At, 1, 0); PG8_STAGE(PG8_SA(0, 1), a2 + hstep, voffA);
            PG8_WAIT_V(8); PG8_WAIT_L(0); PG8_BAR; PG8_MMA(0, 0, At, B0); PG8_MMA(0, 1, At, B1); PG8_BAR; PG8_SCHED;
            PG8_LDA(At, 1, 1); PG8_STAGE(PG8_SB(1, 0), b3, voffB); PG8_STAGE(PG8_SB(1, 1), b3 + hstep, voffB); PG8_STAGE(PG8_SA(1, 0), a3, voffA);
            PG8_WAIT_V(8); PG8_WAIT_L(0); PG8_BAR; PG8_MMA(1, 0, At, B0); PG8_MMA(1, 1, At, B1); PG8_BAR; PG8_SCHED;
            } else {
            PG8_LDB(B0, 0, 0); PG8_SCHED; PG8_LDA(At, 0, 0); PG8_STAGE(PG8_SA(1, 1), a1 + hstep, voffA);
            PG8_WAIT_L(8); PG8_BAR; PG8_WAIT_L(0); PG8_MMA(0, 0, At, B0); PG8_BAR; PG8_SCHED;
            PG8_LDB(B1, 0, 1); PG8_STAGE(PG8_SB(0, 0), b2, voffB);
            PG8_BAR; PG8_WAIT_L(0); PG8_MMA(0, 1, At, B1); PG8_BAR;
            PG8_LDA(At, 0, 1); PG8_STAGE(PG8_SA(0, 0), a2, voffA);
            PG8_BAR; PG8_WAIT_L(0); PG8_MMA(1, 0, At, B0); PG8_BAR; PG8_SCHED;
            PG8_STAGE(PG8_SB(0, 1), b2 + hstep, voffB);
            PG8_WAIT_V(6); PG8_BAR; PG8_MMA(1, 1, At, B1); PG8_BAR;
            PG8_LDB(B0, 1, 0); PG8_SCHED; PG8_LDA(At, 1, 0); PG8_STAGE(PG8_SA(0, 1), a2 + hstep, voffA);
            PG8_WAIT_L(8); PG8_BAR; PG8_WAIT_L(0); PG8_MMA(0, 0, At, B0); PG8_BAR; PG8_SCHED;
            PG8_LDB(B1, 1, 1); PG8_STAGE(PG8_SB(1, 0), b3, voffB);
            PG8_BAR; PG8_WAIT_L(0); PG8_MMA(0, 1, At, B1); PG8_BAR;
            PG8_LDA(At, 1, 1); PG8_STAGE(PG8_SA(1, 0), a3, voffA);
            PG8_BAR; PG8_WAIT_L(0); PG8_MMA(1, 0, At, B0); PG8_BAR; PG8_SCHED;
            PG8_STAGE(PG8_SB(1, 1), b3 + hstep, voffB);
            PG8_WAIT_V(6); PG8_BAR; PG8_MMA(1, 1, At, B1); PG8_BAR;
            }
        }
        if constexpr (ALIGN_EPI) { if (wr == 0) PG8_BAR; }
        if constexpr (!Epi::AFTER_DRAIN) { E(acc, cur, wr, wc, fr, fq); S.done(cur); }
        if (!has_next) break;
#pragma unroll
        for (int a = 0; a < 2; ++a)
#pragma unroll
            for (int b = 0; b < 2; ++b)
#pragma unroll
                for (int m = 0; m < 4; ++m)
#pragma unroll
                    for (int n = 0; n < 2; ++n) acc[a][b][m][n] = (f32x4){0.f, 0.f, 0.f, 0.f};
        cur = nxt; cA = nA; cB = nB; ++ui;
        if constexpr (ALIGN_EPI) { if (wr == 1) PG8_BAR; }
    }
    PG8_WAIT_V(0);
    if constexpr (!ALIGN_EPI) { if (wr == 0) PG8_BAR; }
    PG8_BAR;
    if constexpr (Epi::AFTER_DRAIN) { E.fused(acc, cur, wr, wc, fr, fq, lds, wid, lane); S.done(cur); }
#undef PG8_SA
#undef PG8_SB
#undef PG8_STAGE
#undef PG8_LDA
#undef PG8_LDB
#undef PG8_MMA
#undef PG8_WAIT_V
#undef PG8_WAIT_L
#undef PG8_BAR
#undef PG8_SCHED
}
}
#define LAS __attribute__((address_space(3)))
typedef unsigned short bf16_t;
typedef short bf16x8 __attribute__((ext_vector_type(8)));
typedef float f32x4 __attribute__((ext_vector_type(4)));
typedef float f32x16 __attribute__((ext_vector_type(16)));
typedef unsigned u32x4 __attribute__((ext_vector_type(4)));
typedef unsigned u32x2 __attribute__((ext_vector_type(2)));
typedef float f32x2 __attribute__((ext_vector_type(2)));
using pg8::cvtpk; using pg8::gelu_tanh; using pg8::RMS_EPS;
constexpr int NB = 8, SEQ = 4096, DM = 1024, MTOK = NB * SEQ, DFF = 4096;
constexpr int PROJ_LD = 2048;
constexpr float QK_C2 = 0.125f * 1.4426950408889634f;
constexpr size_t MiB = 1u << 20;
constexpr size_t WS_CTL = 0;
constexpr size_t WS_PART = 1 * MiB;
constexpr size_t WS_LNS = 3 * MiB;
constexpr size_t WS_SMALL = 7 * MiB;
constexpr size_t SM_LRUW = 0;
constexpr size_t SM_WS = 256 * 1024;
constexpr size_t SM_LAM = 768 * 1024;
constexpr size_t WS_WIN = 8 * MiB;
constexpr size_t WS_WOUT = 18 * MiB;
constexpr size_t WS_CIN = 22 * MiB;
constexpr size_t WS_COUT = 30 * MiB;
constexpr size_t WS_W1 = 34 * MiB;
constexpr size_t WS_W2 = 66 * MiB;
constexpr size_t WS_XB = 98 * MiB;
constexpr size_t WS_Y = 162 * MiB;
constexpr size_t WS_H = 226 * MiB;
constexpr size_t WS_VT = WS_H + 128 * MiB;
constexpr size_t WS_END = 482 * MiB;
constexpr int LDS_BYTES = 147456;
constexpr int LDS_CTL = 146432;
constexpr int N_LRU_UNITS = 64, N_ATT_UNITS = NB * 4 * 32;

struct Params { const float* in[26]; float* out; unsigned char* ws; };

__device__ __forceinline__ float bf2f(unsigned short b) { return __uint_as_float((unsigned)b << 16); }
__device__ __forceinline__ float wave_sum(float v) {
#pragma unroll
    for (int o = 1; o < 64; o <<= 1) v += __shfl_xor(v, o);
    return v;
}
__device__ __forceinline__ float xhalf_max(float v) { auto rr = __builtin_amdgcn_permlane32_swap(__float_as_uint(v), __float_as_uint(v), false, false); return fmaxf(__uint_as_float(rr[0]), __uint_as_float(rr[1])); }
__device__ __forceinline__ float xhalf_sum(float v) { auto rr = __builtin_amdgcn_permlane32_swap(__float_as_uint(v), __float_as_uint(v), false, false); return __uint_as_float(rr[0]) + __uint_as_float(rr[1]); }
__device__ __forceinline__ float max3f(float a, float b, float c) { float r; asm("v_max3_f32 %0, %1, %2, %3" : "=v"(r) : "v"(a), "v"(b), "v"(c)); return r; }
__device__ __forceinline__ int crow(int i, int h) { return (i & 3) + 8 * (i >> 2) + 4 * h; }
#define MFMA32(a, b, c) __builtin_amdgcn_mfma_f32_32x32x16_bf16((a), (b), (c), 0, 0, 0)
#define WG_BAR() __syncthreads()

#define XB_TMO      128
#define XB_XCNT(j)  (256  + 64 * (j))
#define XB_XSUB(j)  (1280 + 64 * (j))
#define XB_XGEN(j)  (2304 + 64 * (j))
#define XB_TOP      3328
#define XB_TOPGEN   3392
#define XB_MISM     192
#define XB_LSUB(j)  (3456 + 64 * (j))
#define XB_LGEN(j)  (4480 + 64 * (j))
#define XCD_BAR_WORDS 5504
#define XB_SPIN_CAP (1u << 23)

__device__ __forceinline__ unsigned xb_ld(unsigned* p)              { return __hip_atomic_load(p, __ATOMIC_RELAXED, __HIP_MEMORY_SCOPE_AGENT); }
__device__ __forceinline__ unsigned xb_add(unsigned* p, unsigned v) { return __hip_atomic_fetch_add(p, v, __ATOMIC_RELAXED, __HIP_MEMORY_SCOPE_AGENT); }
__device__ __forceinline__ unsigned xb_xcc_id() { return (unsigned)__builtin_amdgcn_s_getreg((3 << 11) | 20) & 0xFu; }
#define XB_SPIN(cond, bar) do { unsigned _sp = 0; while (cond) { __builtin_amdgcn_s_sleep(1); \
    if ((++_sp & 255u) == 0u) { if (xb_ld(&(bar)[XB_TMO])) break; if (_sp > XB_SPIN_CAP) { atomicAdd(&(bar)[XB_TMO], 1u); break; } } } } while (0)

struct XcdBarrier {
    unsigned* bar; unsigned x;
    volatile LAS unsigned* st;
};

__device__ __forceinline__ XcdBarrier xcd_barrier_post(unsigned* bar, volatile LAS unsigned* st) {
    XcdBarrier b; b.bar = bar; b.x = xb_xcc_id(); b.st = st;
    if (threadIdx.x == 0) {
        if ((blockIdx.x & 7u) != b.x) { (void)xb_add(&bar[XB_MISM], 1u); asm volatile("s_waitcnt vmcnt(0)" ::: "memory"); }
        (void)xb_add(&bar[XB_XCNT(b.x)], 1u);
    }
    return b;
}
__device__ __forceinline__ void xcd_barrier_complete(unsigned* bar, unsigned x, unsigned& nloc, unsigned& nx) {
    const unsigned G = gridDim.x * gridDim.y * gridDim.z;
    unsigned sum, cnt, mine, sp = 0u;
    for (;;) {
        sum = 0u; cnt = 0u; mine = 0u;
#pragma unroll
        for (unsigned j = 0; j < 16; ++j) { const unsigned c = xb_ld(&bar[XB_XCNT(j)]); sum += c; cnt += (c > 0u) ? 1u : 0u; mine = (j == x) ? c : mine; }
        if (sum == G) break;
        __builtin_amdgcn_s_sleep(1);
        if ((++sp & 255u) == 0u) { if (xb_ld(&bar[XB_TMO])) break; if (sp > XB_SPIN_CAP) { atomicAdd(&bar[XB_TMO], 1u); break; } }
    }
    nloc = mine > 0u ? mine : 1u; nx = cnt > 0u ? cnt : 1u;
}

__device__ __forceinline__ void xcd_barrier(const XcdBarrier& b, bool local = false) {
    asm volatile("s_waitcnt vmcnt(0)" ::: "memory");
    __syncthreads();
    if (threadIdx.x == 0) {
        unsigned* bar = b.bar;
        __builtin_amdgcn_s_waitcnt(0);
        unsigned nloc = b.st[0], nx = b.st[1];
        if (nloc == 0u) { xcd_barrier_complete(bar, b.x, nloc, nx); b.st[0] = nloc; b.st[1] = nx; }
        unsigned xx = b.x; asm volatile("" : "+s"(xx));
        const unsigned old = xb_add(&bar[XB_XSUB(xx)], 1u);
        const unsigned gen = old / nloc;
        if (old + 1u == (gen + 1u) * nloc) {
          if (!local) {
            __builtin_amdgcn_fence(__ATOMIC_RELEASE, "agent");
            asm volatile("s_waitcnt vmcnt(0)" ::: "memory");
            const unsigned og = xb_add(&bar[XB_TOP], 1u);
            const unsigned tg = og / nx;
            if (og + 1u == (tg + 1u) * nx) xb_add(&bar[XB_TOPGEN], 1u);
            else XB_SPIN(xb_ld(&bar[XB_TOPGEN]) == tg, bar);
          }
            __builtin_amdgcn_fence(__ATOMIC_ACQUIRE, "agent");
            xb_add(&bar[XB_XGEN(xx)], 1u);
            asm volatile("s_waitcnt vmcnt(0)" ::: "memory");
        } else {
            XB_SPIN(xb_ld(&bar[XB_XGEN(xx)]) == gen, bar);
            __builtin_amdgcn_fence(__ATOMIC_ACQUIRE, "agent");
            asm volatile("s_waitcnt vmcnt(0)" ::: "memory");
        }
    }
    __syncthreads();
}

constexpr int CW_BAR = 16384;

struct P0Item { const float* W; bf16_t* WT; const float* gain; int K, N, k0, n0, r0; float cs; };
__device__ __forceinline__ P0Item p0_decode(const Params& P, unsigned char* ws, int it) {
    constexpr int I_WIN = 16 * 80, I_WOUT = 16 * 32, I_CIN = 16 * 64, I_COUT = 16 * 32, I_W1 = 16 * 128, I_W2 = 64 * 32;
    constexpr int T0 = 2 * I_WIN, T1 = T0 + 2 * I_WOUT, T2 = T1 + 2 * I_CIN, T3 = T2 + 2 * I_COUT, T4 = T3 + 4 * I_W1;
    P0Item d; int mode = 0, item;
    if (it < T0) { const int e = it / I_WIN; item = it % I_WIN; d.W = P.in[4] + (size_t)e * 1024 * 2560; d.K = 1024; d.N = 2560; d.WT = (bf16_t*)(ws + WS_WIN) + (size_t)e * 2560 * 1024; d.gain = P.in[1] + (2 * e) * 1024; mode = 1; }
    else if (it < T1) { const int e = (it - T0) / I_WOUT; item = (it - T0) % I_WOUT; d.W = P.in[17] + (size_t)e * 1024 * 1024; d.K = 1024; d.N = 1024; d.WT = (bf16_t*)(ws + WS_WOUT) + (size_t)e * 1024 * 1024; d.gain = nullptr; }
    else if (it < T2) { const int o = (it - T1) / I_CIN; item = (it - T1) % I_CIN; d.W = P.in[18] + (size_t)o * 1024 * 2048; d.K = 1024; d.N = 2048; d.WT = (bf16_t*)(ws + WS_CIN) + (size_t)o * 2048 * 1024; d.gain = P.in[1] + (2 * o + 1) * 1024; }
    else if (it < T3) { const int o = (it - T2) / I_COUT; item = (it - T2) % I_COUT; d.W = P.in[23] + (size_t)o * 1024 * 1024; d.K = 1024; d.N = 1024; d.WT = (bf16_t*)(ws + WS_COUT) + (size_t)o * 1024 * 1024; d.gain = nullptr; }
    else if (it < T4) { const int l = (it - T3) / I_W1; item = (it - T3) % I_W1; d.W = P.in[24] + (size_t)l * 1024 * 4096; d.K = 1024; d.N = 4096; d.WT = (bf16_t*)(ws + WS_W1) + (size_t)l * 4096 * 1024; d.gain = P.in[2] + l * 1024; }
    else { const int l = (it - T4) / I_W2; item = (it - T4) % I_W2; d.W = P.in[25] + (size_t)l * 4096 * 1024; d.K = 4096; d.N = 1024; d.WT = (bf16_t*)(ws + WS_W2) + (size_t)l * 1024 * 4096; d.gain = nullptr; }
    const int nblk = d.N / 32, kb = item / nblk, nb = item % nblk; d.k0 = 64 * kb; d.n0 = 32 * nb; d.cs = 1.0f; d.r0 = d.n0;
    if (mode == 1) { if (d.n0 < 512) d.cs = QK_C2; d.r0 = (d.n0 < 1024) ? d.n0 : ((d.n0 < 1536) ? d.n0 + 1024 : d.n0 - 512); }
    return d;
}
__device__ __forceinline__ void p0_load(const P0Item& d, int lane, f32x4 (&v)[8], float (&g)[8]) {
#pragma unroll
    for (int i = 0; i < 8; ++i) { const int kk = 8 * i + (lane >> 3), c4 = lane & 7;
        v[i] = __builtin_nontemporal_load((const f32x4*)(d.W + (size_t)(d.k0 + kk) * d.N + d.n0 + 4 * c4));
        g[i] = d.gain ? d.gain[d.k0 + kk] * d.cs : d.cs; }
}
__device__ __forceinline__ void p0_store(const P0Item& d, int lane, const f32x4 (&v)[8], const float (&g)[8], LAS float* scr) {
#pragma unroll
    for (int i = 0; i < 8; ++i) { const int kk = 8 * i + (lane >> 3), c4 = lane & 7;
        scr[kk * 33 + 4 * c4 + 0] = v[i][0] * g[i]; scr[kk * 33 + 4 * c4 + 1] = v[i][1] * g[i]; scr[kk * 33 + 4 * c4 + 2] = v[i][2] * g[i]; scr[kk * 33 + 4 * c4 + 3] = v[i][3] * g[i]; }
    asm volatile("s_waitcnt lgkmcnt(0)" ::: "memory");
    const int c = lane & 7;
#pragma unroll
    for (int j = 0; j < 4; ++j) { const int n = (lane >> 3) + 8 * j; const LAS float* s = scr + (8 * c) * 33 + n;
        u32x4 o; o.x = cvtpk(s[0 * 33], s[1 * 33]); o.y = cvtpk(s[2 * 33], s[3 * 33]); o.z = cvtpk(s[4 * 33], s[5 * 33]); o.w = cvtpk(s[6 * 33], s[7 * 33]);
        __builtin_nontemporal_store(o, (u32x4*)(d.WT + (size_t)(d.r0 + n) * d.K + d.k0 + 8 * c)); }
    asm volatile("s_waitcnt lgkmcnt(0)" ::: "memory");
}
__device__ __forceinline__ void prologue_phase(const Params& P, LAS unsigned char* lds) {
    int tid_ = threadIdx.x; asm volatile("" : "+v"(tid_));
    const int tid = tid_, lane = tid & 63, wave = tid >> 6;
    const int gw = blockIdx.x * 8 + wave, NGW = gridDim.x * 8;
    const int gt = blockIdx.x * 512 + tid, NGT = gridDim.x * 512;
    unsigned char* ws = P.ws;
    if (gt < 64) ((unsigned*)(ws + WS_CTL))[gt] = 0u;
    if (gt < XCD_BAR_WORDS) ((unsigned*)(ws + WS_CTL))[CW_BAR + gt] = 0u;
    if (blockIdx.x == 0 && wave < 2) {
        const int e = wave;
        const float a = wave_sum(P.in[5][e * 64 + lane] * P.in[6][e * 64 + lane]);
        const float b = wave_sum(P.in[7][e * 64 + lane] * P.in[8][e * 64 + lane]);
        const float lam_init = (e == 0) ? 0.2f : (0.8f - 0.6f * 0.54881163609f);
        if (lane == 0) ((float*)(ws + WS_SMALL + SM_LAM))[e] = expf(a) - expf(b) + lam_init;
    }
    {
        bf16_t* dst = (bf16_t*)(ws + WS_SMALL + SM_LRUW);
        for (int t = gt; t < 2 * 2 * 8 * 4096; t += NGT) {
            const int i = t & 63, j = (t >> 6) & 63, h = (t >> 12) & 7, mat = (t >> 15) & 1, e = t >> 16;
            const float v = P.in[mat ? 14 : 12][((size_t)(e * 8 + h) * 64 + i) * 64 + j];
            dst[t] = (bf16_t)(cvtpk(v * -1.4426950408889634f, 0.f) & 0xffffu);
        }
    }
    {
        bf16_t* dst = (bf16_t*)(ws + WS_SMALL + SM_WS);
        for (int t = gt; t < 2 * 8 * 128 * 128; t += NGT) {
            const int q = t & 127, p = (t >> 7) & 127;
            const float v = ((q >> 6) <= (p >> 6)) ? P.in[21][t] : 0.f;
            dst[t] = (bf16_t)(cvtpk(v, 0.f) & 0xffffu);
        }
    }
    {
        LAS float* scr = (LAS float*)(lds + wave * 16384);
        constexpr int NITEMS = 2 * 16 * 80 + 2 * 16 * 32 + 2 * 16 * 64 + 2 * 16 * 32 + 4 * 16 * 128 + 4 * 64 * 32;
        int it = gw; P0Item d; f32x4 v[8]; float g[8];
        if (it < NITEMS) { d = p0_decode(P, ws, it); p0_load(d, lane, v, g); }
        while (it < NITEMS) {
            const int itn = it + NGW; P0Item dn = d; f32x4 vn[8]; float gn[8];
#pragma unroll
            for (int i = 0; i < 8; ++i) { vn[i] = v[i]; gn[i] = g[i]; }
            if (itn < NITEMS) { dn = p0_decode(P, ws, itn); p0_load(dn, lane, vn, gn); }
            p0_store(d, lane, v, g, scr);
            d = dn; it = itn;
#pragma unroll
            for (int i = 0; i < 8; ++i) { v[i] = vn[i]; g[i] = gn[i]; }
        }
    }
    {
        const float* x = P.in[0]; bf16_t* xb = (bf16_t*)(ws + WS_XB); float* part = (float*)(ws + WS_PART);
        for (int m = gw; m < MTOK; m += 2 * NGW) {
            const int m1 = m + NGW;
            const bool two = m1 < MTOK;
            const f32x4* xr0 = (const f32x4*)(x + (size_t)m * DM) + lane;
            const f32x4* xr1 = (const f32x4*)(x + (size_t)(two ? m1 : m) * DM) + lane;
            f32x4 v0[4], v1[4]; float s0 = 0.f, s1 = 0.f;
#pragma unroll
            for (int j = 0; j < 4; ++j) { v0[j] = __builtin_nontemporal_load(xr0 + 64 * j); v1[j] = __builtin_nontemporal_load(xr1 + 64 * j); }
#pragma unroll
            for (int j = 0; j < 4; ++j) { s0 += (v0[j][0] * v0[j][0] + v0[j][1] * v0[j][1]) + (v0[j][2] * v0[j][2] + v0[j][3] * v0[j][3]);
                                          s1 += (v1[j][0] * v1[j][0] + v1[j][1] * v1[j][1]) + (v1[j][2] * v1[j][2] + v1[j][3] * v1[j][3]); }
            s0 = wave_sum(s0); s1 = wave_sum(s1);
            u32x2* o0 = (u32x2*)(xb + (size_t)m * DM) + lane;
#pragma unroll
            for (int j = 0; j < 4; ++j) { u32x2 w; w.x = cvtpk(v0[j][0], v0[j][1]); w.y = cvtpk(v0[j][2], v0[j][3]); o0[64 * j] = w; }
            if (lane < 16) part[(size_t)m * 16 + lane] = s0 * (1.0f / 16.0f);
            if (two) {
                u32x2* o1 = (u32x2*)(xb + (size_t)m1 * DM) + lane;
#pragma unroll
                for (int j = 0; j < 4; ++j) { u32x2 w; w.x = cvtpk(v1[j][0], v1[j][1]); w.y = cvtpk(v1[j][2], v1[j][3]); o1[64 * j] = w; }
                if (lane < 16) part[(size_t)m1 * 16 + lane] = s1 * (1.0f / 16.0f);
            }
        }
    }
}

constexpr int AT_KS = 272, AT_VS = 144, AT_KBYTES = 64 * AT_KS, AT_VBYTES = 128 * AT_VS, AT_BUF = AT_KBYTES + AT_VBYTES;
__device__ __forceinline__ void attn_unit(const bf16_t* __restrict__ proj, const bf16_t* __restrict__ vt, bf16_t* __restrict__ Y, const float* __restrict__ subln, float lam, float out_scale,
                                          int b, int h, int qb, unsigned* qnext, unsigned& pre, LAS unsigned char* lds) {
    int tid_ = threadIdx.x; asm volatile("" : "+v"(tid_));
    const int tid = tid_, lane = tid & 63, w = __builtin_amdgcn_readfirstlane(tid >> 6), r = lane & 31, hh = lane >> 5;
    const int mp = w & 1, jg = w >> 1;
    const size_t rowbase = (size_t)b * SEQ;
    const int NT = 2 * qb + 2, cw = 2 * qb + (jg >> 1);
    bf16x8 qf[4];
    { const bf16_t* qp = proj + (rowbase + qb * 128 + jg * 32 + r) * PROJ_LD + h * 128 + mp * 64 + hh * 8;
#pragma unroll
      for (int ks = 0; ks < 4; ++ks) qf[ks] = *(const bf16x8*)(qp + ks * 16); }
    const char* kgb = (const char*)(proj + rowbase * PROJ_LD + 512 + h * 128);
    const char* vgb = (const char*)(vt + (size_t)(b * 4 + h) * 64 * 128 * 64);
    unsigned kg[2], vg[2]; int kl[2], vl[2];
#pragma unroll
    for (int i = 0; i < 2; ++i) { const int c = tid + 512 * i;
        kg[i] = (unsigned)((c >> 4) * PROJ_LD + (c & 15) * 8) * 2u; kl[i] = (c >> 4) * AT_KS + (c & 15) * 16;
        vg[i] = (unsigned)((c >> 3) * 64 + (c & 7) * 8) * 2u; vl[i] = AT_KBYTES + (c >> 3) * AT_VS + (c & 7) * 16; }
    const int pir = (r & 3) + 4 * ((r >> 3) & 1) + 8 * ((r >> 2) & 1) + 16 * (r >> 4);
    const int kbase = pir * AT_KS + mp * 128 + hh * 16, vbase = AT_KBYTES + r * AT_VS + hh * 16;
    u32x4 kreg[2], vreg[2];
#pragma unroll
    for (int i = 0; i < 2; ++i) { kreg[i] = *(const u32x4*)(kgb + kg[i]); vreg[i] = *(const u32x4*)(vgb + vg[i]); }
#pragma unroll
    for (int i = 0; i < 2; ++i) { *(LAS u32x4*)(lds + kl[i]) = kreg[i]; *(LAS u32x4*)(lds + vl[i]) = vreg[i]; }
    WG_BAR();
    float m_run = 0.f, l_run = 0.f;
    asm volatile("" : "+v"(m_run));
    f32x16 o[4];
#pragma unroll
    for (int nb = 0; nb < 4; ++nb)
#pragma unroll
        for (int i = 0; i < 16; ++i) o[nb][i] = 0.f;
    for (int t = 0; t < NT; ++t) {
        const int boff = (t & 1) * AT_BUF, noff = ((t + 1) & 1) * AT_BUF;
        const bool more = (t + 1 < NT);
        if (more) {
#pragma unroll
            for (int i = 0; i < 2; ++i) { kreg[i] = *(const u32x4*)(kgb + (kg[i] + (unsigned)(t + 1) * (64u * PROJ_LD * 2u))); vreg[i] = *(const u32x4*)(vgb + (vg[i] + (unsigned)(t + 1) * 16384u)); }
        }
        if (t <= cw) {
            f32x16 s0, s1;
#pragma unroll
            for (int i = 0; i < 16; ++i) { s0[i] = 0.f; s1[i] = 0.f; }
            const LAS unsigned char* kb = lds + boff + kbase;
            const LAS unsigned char* vb = lds + boff + vbase;
            bf16x8 kf0[4], kf1[4];
#pragma unroll
            for (int ks = 0; ks < 4; ++ks) { kf0[ks] = *(const LAS bf16x8*)(kb + ks * 32); kf1[ks] = *(const LAS bf16x8*)(kb + 32 * AT_KS + ks * 32); }
            __builtin_amdgcn_sched_barrier(0);
#pragma unroll
            for (int ks = 0; ks < 4; ++ks) { s0 = MFMA32(kf0[ks], qf[ks], s0); s1 = MFMA32(kf1[ks], qf[ks], s1); }
            bf16x8 vf[16];
#pragma unroll
            for (int nb = 0; nb < 4; ++nb)
#pragma unroll
                for (int kk = 0; kk < 4; ++kk) vf[nb * 4 + kk] = *(const LAS bf16x8*)(vb + nb * 32 * AT_VS + kk * 32);
            __builtin_amdgcn_sched_barrier(0);
#pragma unroll
            for (int i = 0; i < 16; ++i) { s0[i] -= m_run; s1[i] -= m_run; }
            float mxa = max3f(s0[0], s0[1], s0[2]), mxb = max3f(s1[0], s1[1], s1[2]);
#pragma unroll
            for (int i = 3; i < 15; i += 2) { mxa = max3f(mxa, s0[i], s0[i + 1]); mxb = max3f(mxb, s1[i], s1[i + 1]); }
            float mx = max3f(mxa, mxb, s0[15]); mx = max3f(mx, s1[15], s1[15]);
            mx = xhalf_max(mx);
            const bool upd = (t == 0) || (mx > 8.0f);
            if (__any(upd)) {
                const float dl = upd ? mx : 0.f;
                m_run += dl;
#pragma unroll
                for (int i = 0; i < 16; ++i) { s0[i] -= dl; s1[i] -= dl; }
                if (t != 0) {
                    const float alpha = __builtin_amdgcn_exp2f(-dl);
                    l_run *= alpha;
#pragma unroll
                    for (int nb = 0; nb < 4; ++nb)
#pragma unroll
                        for (int i = 0; i < 16; ++i) o[nb][i] *= alpha;
                }
            }
            float ps = 0.f;
            bf16x8 pf[4];
#define AT_EXPQ(S, B, K) do { _Pragma("unroll") for (int i_ = 0; i_ < 8; ++i_) { S[(B) + i_] = __builtin_amdgcn_exp2f(S[(B) + i_]); ps += S[(B) + i_]; } \
              u32x4 a_; a_.x = cvtpk(S[(B) + 0], S[(B) + 1]); a_.y = cvtpk(S[(B) + 2], S[(B) + 3]); a_.z = cvtpk(S[(B) + 4], S[(B) + 5]); a_.w = cvtpk(S[(B) + 6], S[(B) + 7]); pf[K] = __builtin_bit_cast(bf16x8, a_); } while (0)
#define AT_PVQ(K) do { _Pragma("unroll") for (int nb_ = 0; nb_ < 4; ++nb_) o[nb_] = MFMA32(vf[nb_ * 4 + (K)], pf[K], o[nb_]); } while (0)
#define AT_MIX() do { _Pragma("unroll") for (int g_ = 0; g_ < 4; ++g_) { __builtin_amdgcn_sched_group_barrier(0x008, 1, 0); __builtin_amdgcn_sched_group_barrier(0x402, 7, 0); } __builtin_amdgcn_sched_barrier(0); } while (0)
            AT_EXPQ(s0, 0, 0);
            __builtin_amdgcn_sched_barrier(0);
            AT_PVQ(0); AT_EXPQ(s0, 8, 1); AT_MIX();
            AT_PVQ(1); AT_EXPQ(s1, 0, 2); AT_MIX();
            AT_PVQ(2); AT_EXPQ(s1, 8, 3); AT_MIX();
            AT_PVQ(3);
#undef AT_EXPQ
#undef AT_PVQ
#undef AT_MIX
            l_run += ps;
        }
        if (more) {
#pragma unroll
            for (int i = 0; i < 2; ++i) { *(LAS u32x4*)(lds + noff + kl[i]) = kreg[i]; *(LAS u32x4*)(lds + noff + vl[i]) = vreg[i]; }
        }
        WG_BAR();
    }
    if (tid == 0) pre = atomicAdd(qnext, 1u);
    const float l_tot = xhalf_sum(l_run);
    const float inv = 1.0f / l_tot;
    LAS float* ex = (LAS float*)lds + jg * 4096;
    if (mp == 1) {
        const float sc = lam * inv;
#pragma unroll
        for (int nb = 0; nb < 4; ++nb)
#pragma unroll
            for (int i = 0; i < 16; ++i) ex[(nb * 16 + i) * 64 + lane] = o[nb][i] * sc;
    }
    WG_BAR();
    if (mp == 0) {
        float ss = 0.f;
#pragma unroll
        for (int nb = 0; nb < 4; ++nb)
#pragma unroll
            for (int i = 0; i < 16; ++i) { const float d = o[nb][i] * inv - ex[(nb * 16 + i) * 64 + lane]; o[nb][i] = d; ss += d * d; }
        ss = xhalf_sum(ss);
        const float rstd = rsqrtf(ss * (1.0f / 128.0f) + RMS_EPS) * out_scale;
        bf16_t* yp = Y + (rowbase + qb * 128 + jg * 32 + r) * DM + h * 128 + 4 * hh;
#pragma unroll
        for (int nb = 0; nb < 4; ++nb)
#pragma unroll
            for (int g4 = 0; g4 < 4; ++g4) {
                const int n0 = 32 * nb + 8 * g4;
                const f32x4 gg = *(const f32x4*)(subln + n0 + 4 * hh);
                u32x2 wv; wv.x = cvtpk(o[nb][4 * g4 + 0] * rstd * gg[0], o[nb][4 * g4 + 1] * rstd * gg[1]); wv.y = cvtpk(o[nb][4 * g4 + 2] * rstd * gg[2], o[nb][4 * g4 + 3] * rstd * gg[3]);
                *(u32x2*)(yp + n0) = wv;
            }
    }
    WG_BAR();
}

constexpr int LR_XS = 68;
constexpr int LR_WAVE_BYTES = 32 * LR_XS * 4 + 32 * 64 * 4;
constexpr int LR_CW_OFF = 8 * LR_WAVE_BYTES;
typedef short s16x2_t __attribute__((ext_vector_type(2)));
__device__ __forceinline__ float ldbf(const char* p) { s16x2_t t = {0, *(const short*)p}; return __builtin_bit_cast(float, t); }
__device__ __forceinline__ float sigmoidf_(float x) { return __builtin_amdgcn_rcpf(1.0f + __builtin_amdgcn_exp2f(-1.4426950408889634f * x)); }
__device__ __forceinline__ void lru_unit(const Params& P, int e, int b, int hd, LAS unsigned char* lds) {
    int tid_ = threadIdx.x; asm volatile("" : "+v"(tid_));
    const int tid = tid_, lane = tid & 63, w = __builtin_amdgcn_readfirstlane(tid >> 6), r = lane & 31, hh = lane >> 5;
    const bf16_t* proj = (const bf16_t*)(P.ws + WS_H); bf16_t* Y = (bf16_t*)(P.ws + WS_Y);
    const size_t rowbase = (size_t)b * SEQ;
    const int chg = hd * 64 + lane;
    bf16x8 waf[2][4], wxf[2][4];
    { const bf16_t* wt = (const bf16_t*)(P.ws + WS_SMALL + SM_LRUW) + (size_t)e * 2 * 8 * 4096;
#pragma unroll
      for (int nt = 0; nt < 2; ++nt)
#pragma unroll
          for (int ks = 0; ks < 4; ++ks) {
              waf[nt][ks] = *(const bf16x8*)(wt + (size_t)(0 * 8 + hd) * 4096 + (32 * nt + r) * 64 + 16 * ks + 8 * hh);
              wxf[nt][ks] = *(const bf16x8*)(wt + (size_t)(1 * 8 + hd) * 4096 + (32 * nt + r) * 64 + 16 * ks + 8 * hh);
          } }
    float ba_[2], bx_[2], c8_[2];
#pragma unroll
    for (int nt = 0; nt < 2; ++nt) { const int c = e * 512 + hd * 64 + 32 * nt + r; ba_[nt] = -1.4426950408889634f * P.in[13][c]; bx_[nt] = -1.4426950408889634f * P.in[15][c];
        c8_[nt] = -8.0f * 1.4426950408889634f * log1pf(expf(-P.in[16][c])); }
    const float cw0 = P.in[10][(e * 4 + 0) * 512 + chg], cw1 = P.in[10][(e * 4 + 1) * 512 + chg], cw2 = P.in[10][(e * 4 + 2) * 512 + chg], cw3 = P.in[10][(e * 4 + 3) * 512 + chg];
    const float cb = P.in[11][e * 512 + chg];
    LAS float* xs = (LAS float*)(lds + w * LR_WAVE_BYTES);
    LAS float* bs = (LAS float*)(lds + w * LR_WAVE_BYTES + 32 * LR_XS * 4);
    LAS f32x2* cwl = (LAS f32x2*)(lds + LR_CW_OFF);
    float carry = 0.f;
    const bf16_t* xblk = proj + rowbase * PROJ_LD + 1024 + hd * 64;
    const bf16_t* gblk = proj + rowbase * PROJ_LD + 1536 + hd * 64;
    bf16_t* yblk = Y + rowbase * DM + 512 + hd * 64;
    float xr[35];
    const char* xbase = (const char*)xblk; const char* gbase = (const char*)gblk; char* ybase = (char*)yblk;
    { const unsigned xo = (unsigned)(w * 32) * (PROJ_LD * 2) + lane * 2;
#pragma unroll
      for (int j = 0; j < 3; ++j) xr[j] = 0.f;
      if (w > 0) {
#pragma unroll
          for (int j = 0; j < 3; ++j) xr[j] = ldbf(xbase + (xo - (unsigned)(3 - j) * (PROJ_LD * 2)));
      }
#pragma unroll
      for (int pp = 0; pp < 32; ++pp) xr[3 + pp] = ldbf(xbase + (xo + (unsigned)pp * (PROJ_LD * 2))); }
    for (int tile = 0; tile < SEQ / 256; ++tile) {
        const int p0 = tile * 256 + w * 32;
        {
            float xm3 = xr[0], xm2 = xr[1], xm1 = xr[2];
#pragma unroll
            for (int pp = 0; pp < 32; ++pp) {
                const float x0 = xr[3 + pp];
                xs[pp * LR_XS + lane] = cb + cw0 * xm3 + cw1 * xm2 + cw2 * xm1 + cw3 * x0;
                xm3 = xm2; xm2 = xm1; xm1 = x0;
            }
        }
        f32x16 ga[2], gx[2];
#pragma unroll
        for (int nt = 0; nt < 2; ++nt)
#pragma unroll
            for (int i = 0; i < 16; ++i) { ga[nt][i] = 0.f; gx[nt][i] = 0.f; }
#pragma unroll
        for (int ks = 0; ks < 4; ++ks) {
            const f32x4 a0 = *(const LAS f32x4*)(xs + r * LR_XS + 16 * ks + 8 * hh), a1 = *(const LAS f32x4*)(xs + r * LR_XS + 16 * ks + 8 * hh + 4);
            u32x4 pk; pk.x = cvtpk(a0[0], a0[1]); pk.y = cvtpk(a0[2], a0[3]); pk.z = cvtpk(a1[0], a1[1]); pk.w = cvtpk(a1[2], a1[3]);
            const bf16x8 af = __builtin_bit_cast(bf16x8, pk);
#pragma unroll
            for (int nt = 0; nt < 2; ++nt) { ga[nt] = MFMA32(af, waf[nt][ks], ga[nt]); gx[nt] = MFMA32(af, wxf[nt][ks], gx[nt]); }
        }
#pragma unroll
        for (int nt = 0; nt < 2; ++nt)
#pragma unroll
            for (int i = 0; i < 16; ++i) {
                const int pos = crow(i, hh), ch = 32 * nt + r;
                const float rg = __builtin_amdgcn_rcpf(1.0f + __builtin_amdgcn_exp2f(ga[nt][i] + ba_[nt])), ig = __builtin_amdgcn_rcpf(1.0f + __builtin_amdgcn_exp2f(gx[nt][i] + bx_[nt]));
                const float a = __builtin_amdgcn_exp2f(c8_[nt] * rg);
                const float mult = __builtin_amdgcn_sqrtf(fmaxf(1.0f - a * a, 0.f));
                const float xc = xs[pos * LR_XS + ch];
                xs[pos * LR_XS + ch] = a;
                bs[pos * 64 + ch] = mult * ig * xc;
            }
        float gr[32];
        { const unsigned go = (unsigned)p0 * (PROJ_LD * 2) + lane * 2;
#pragma unroll
          for (int pp = 0; pp < 32; ++pp) gr[pp] = ldbf(gbase + (go + (unsigned)pp * (PROJ_LD * 2))); }
        if (tile + 1 < SEQ / 256) {
            const unsigned xo = (unsigned)(p0 + 256 - 3) * (PROJ_LD * 2) + lane * 2;
#pragma unroll
            for (int j = 0; j < 35; ++j) xr[j] = ldbf(xbase + (xo + (unsigned)j * (PROJ_LD * 2)));
        }
        {
            float hl = 0.f, cp = 1.f;
#pragma unroll 8
            for (int pp = 0; pp < 32; ++pp) {
                const float a = xs[pp * LR_XS + lane], bt = bs[pp * 64 + lane];
                hl = a * hl + bt; cp *= a;
                bs[pp * 64 + lane] = hl; xs[pp * LR_XS + lane] = cp;
            }
            cwl[((tile & 1) * 8 + w) * 64 + lane] = (f32x2){cp, hl};
        }
        WG_BAR();
        {
            float cin = carry, call = carry;
#pragma unroll
            for (int ww = 0; ww < 8; ++ww) { const f32x2 ab = cwl[((tile & 1) * 8 + ww) * 64 + lane]; call = ab[0] * call + ab[1]; if (ww + 1 == w) cin = call; }
            carry = call;
            const unsigned yo = (unsigned)p0 * (DM * 2) + lane * 2;
#pragma unroll
            for (int pp = 0; pp < 32; ++pp) {
                const float hv = bs[pp * 64 + lane] + xs[pp * LR_XS + lane] * cin;
                *(bf16_t*)(ybase + (yo + (unsigned)pp * (DM * 2))) = (bf16_t)(cvtpk(gr[pp] * hv, 0.f) & 0xffffu);
            }
        }
    }
    WG_BAR();
}

constexpr int SG_RS = 288, SG_IMG = 128 * SG_RS, SG_STAT = SG_IMG, SG_OUT = SG_IMG + 1024, SG_OS = 132;
typedef short v4i16_t __attribute__((ext_vector_type(4)));
__device__ __forceinline__ v4i16_t lds_tr16(const LAS unsigned char* p) { return __builtin_amdgcn_ds_read_tr16_b64_v4i16((LAS v4i16_t*)p); }
__device__ __forceinline__ void sgu_unit(const Params& P, int o, int unit, LAS unsigned char* lds) {
    int tid_ = threadIdx.x; asm volatile("" : "+v"(tid_));
    const int tid = tid_, lane = tid & 63, w = __builtin_amdgcn_readfirstlane(tid >> 6), r = lane & 31, hh = lane >> 5;
    const bf16_t* Z = (const bf16_t*)(P.ws + WS_H); bf16_t* Y = (bf16_t*)(P.ws + WS_Y);
    const int g = unit & 7; const size_t row0 = (size_t)(unit >> 3) * 128;
    const int c16 = tid & 15, qt = tid >> 4;
    LAS f32x2* stat = (LAS f32x2*)(lds + SG_STAT);
    if (tid < 128) {
        const f32x4* lp = (const f32x4*)((const float*)(P.ws + WS_LNS) + (row0 + tid) * 32);
        float sum = 0.f, sq = 0.f;
#pragma unroll
        for (int i = 0; i < 8; ++i) { const f32x4 t = lp[i]; sum += t[0] + t[2]; sq += t[1] + t[3]; }
        const float mean = sum * (1.0f / 1024.0f), var = sq * (1.0f / 1024.0f) - mean * mean;
        stat[tid] = (f32x2){mean, rsqrtf(var + RMS_EPS)};
    }
    u32x4 zraw[4], uraw[4];
#pragma unroll
    for (int i = 0; i < 4; ++i) { const bf16_t* zp = Z + (row0 + qt + 32 * i) * PROJ_LD + g * 128 + c16 * 8; zraw[i] = *(const u32x4*)(zp + 1024); uraw[i] = *(const u32x4*)zp; }
    float lg[8], lb[8];
    { const float* gp = P.in[19] + o * 1024 + g * 128 + c16 * 8; const float* bp = P.in[20] + o * 1024 + g * 128 + c16 * 8;
      const f32x4 g0 = *(const f32x4*)gp, g1 = *(const f32x4*)(gp + 4), b0 = *(const f32x4*)bp, b1 = *(const f32x4*)(bp + 4);
#pragma unroll
      for (int e2 = 0; e2 < 4; ++e2) { lg[e2] = g0[e2]; lg[4 + e2] = g1[e2]; lb[e2] = b0[e2]; lb[4 + e2] = b1[e2]; } }
    WG_BAR();
#pragma unroll
    for (int i = 0; i < 4; ++i) {
        const int q = qt + 32 * i; const f32x2 st = stat[q]; const u32x4 raw = zraw[i];
        float v[8];
        v[0] = __uint_as_float(raw.x << 16); v[1] = __uint_as_float(raw.x & 0xffff0000u); v[2] = __uint_as_float(raw.y << 16); v[3] = __uint_as_float(raw.y & 0xffff0000u);
        v[4] = __uint_as_float(raw.z << 16); v[5] = __uint_as_float(raw.z & 0xffff0000u); v[6] = __uint_as_float(raw.w << 16); v[7] = __uint_as_float(raw.w & 0xffff0000u);
#pragma unroll
        for (int e2 = 0; e2 < 8; ++e2) v[e2] = (v[e2] - st[0]) * st[1] * lg[e2] + lb[e2];
        u32x4 pk; pk.x = cvtpk(v[0], v[1]); pk.y = cvtpk(v[2], v[3]); pk.z = cvtpk(v[4], v[5]); pk.w = cvtpk(v[6], v[7]);
        *(LAS u32x4*)(lds + q * SG_RS + c16 * 16) = pk;
    }
    WG_BAR();
    const int pb = w >> 1, cb0 = (w & 1) * 2;
    f32x16 acc[2];
#pragma unroll
    for (int cc = 0; cc < 2; ++cc)
#pragma unroll
        for (int i = 0; i < 16; ++i) acc[cc][i] = 0.f;
    const bf16_t* wsm = (const bf16_t*)(P.ws + WS_SMALL + SM_WS) + ((size_t)(o * 8 + g) * 128 + 32 * pb + r) * 128 + 8 * hh;
    const int trb = (8 * hh + ((lane & 15) >> 2)) * SG_RS + (16 * ((lane >> 4) & 1) + 4 * (lane & 3)) * 2;
#pragma unroll
    for (int ks = 0; ks < 8; ++ks) {
        if (pb >= 2 || ks < 4) {
            const bf16x8 af = *(const bf16x8*)(wsm + 16 * ks);
#pragma unroll
            for (int cc = 0; cc < 2; ++cc) {
                const LAS unsigned char* tp = lds + trb + 16 * ks * SG_RS + 32 * (cb0 + cc) * 2;
                const v4i16_t lo = lds_tr16(tp), hi = lds_tr16(tp + 4 * SG_RS);
                const bf16x8 bfr = (bf16x8){lo[0], lo[1], lo[2], lo[3], hi[0], hi[1], hi[2], hi[3]};
                acc[cc] = MFMA32(af, bfr, acc[cc]);
            }
        }
    }
    const float* bsp = P.in[22] + (o * 8 + g) * 128 + 32 * pb;
    LAS float* oimg = (LAS float*)(lds + SG_OUT);
#pragma unroll
    for (int cc = 0; cc < 2; ++cc)
#pragma unroll
        for (int i = 0; i < 16; ++i) { const int pl = crow(i, hh); oimg[(32 * pb + pl) * SG_OS + 32 * (cb0 + cc) + r] = acc[cc][i] + bsp[pl]; }
    WG_BAR();
#pragma unroll
    for (int i = 0; i < 4; ++i) {
        const int p = qt + 32 * i; const u32x4 raw = uraw[i];
        const f32x4 m0 = *(const LAS f32x4*)(oimg + p * SG_OS + c16 * 8), m1 = *(const LAS f32x4*)(oimg + p * SG_OS + c16 * 8 + 4);
        u32x4 pk;
        pk.x = cvtpk(__uint_as_float(raw.x << 16) * m0[0], __uint_as_float(raw.x & 0xffff0000u) * m0[1]); pk.y = cvtpk(__uint_as_float(raw.y << 16) * m0[2], __uint_as_float(raw.y & 0xffff0000u) * m0[3]);
        pk.z = cvtpk(__uint_as_float(raw.z << 16) * m1[0], __uint_as_float(raw.z & 0xffff0000u) * m1[1]); pk.w = cvtpk(__uint_as_float(raw.w << 16) * m1[2], __uint_as_float(raw.w & 0xffff0000u) * m1[3]);
        *(u32x4*)(Y + (row0 + p) * DM + g * 128 + c16 * 8) = pk;
    }
}

__device__ __forceinline__ void final_norm_phase(const Params& P) {
    int tid_ = threadIdx.x; asm volatile("" : "+v"(tid_));
    const int tid = tid_, lane = tid & 63, wave = tid >> 6;
    const int gw = blockIdx.x * 8 + wave, NGW = gridDim.x * 8;
    const bf16_t* xb = (const bf16_t*)(P.ws + WS_XB);
    const f32x4* gp = (const f32x4*)P.in[3] + lane;
    f32x4 gv[4];
#pragma unroll
    for (int j = 0; j < 4; ++j) gv[j] = gp[64 * j];
    for (int m = gw; m < MTOK; m += 2 * NGW) {
        const int m1 = (m + NGW < MTOK) ? m + NGW : m;
        const u32x2* xr0 = (const u32x2*)(xb + (size_t)m * DM) + lane;
        const u32x2* xr1 = (const u32x2*)(xb + (size_t)m1 * DM) + lane;
        u32x2 t0[4], t1[4];
#pragma unroll
        for (int j = 0; j < 4; ++j) { t0[j] = xr0[64 * j]; t1[j] = xr1[64 * j]; }
        f32x4 v0[4], v1[4]; float s0 = 0.f, s1 = 0.f;
#pragma unroll
        for (int j = 0; j < 4; ++j) {
            v0[j][0] = __uint_as_float(t0[j].x << 16); v0[j][1] = __uint_as_float(t0[j].x & 0xffff0000u); v0[j][2] = __uint_as_float(t0[j].y << 16); v0[j][3] = __uint_as_float(t0[j].y & 0xffff0000u);
            v1[j][0] = __uint_as_float(t1[j].x << 16); v1[j][1] = __uint_as_float(t1[j].x & 0xffff0000u); v1[j][2] = __uint_as_float(t1[j].y << 16); v1[j][3] = __uint_as_float(t1[j].y & 0xffff0000u);
            s0 += (v0[j][0] * v0[j][0] + v0[j][1] * v0[j][1]) + (v0[j][2] * v0[j][2] + v0[j][3] * v0[j][3]);
            s1 += (v1[j][0] * v1[j][0] + v1[j][1] * v1[j][1]) + (v1[j][2] * v1[j][2] + v1[j][3] * v1[j][3]); }
        const float rs0 = rsqrtf(wave_sum(s0) * (1.0f / 1024.0f) + RMS_EPS), rs1 = rsqrtf(wave_sum(s1) * (1.0f / 1024.0f) + RMS_EPS);
        f32x4* o0 = (f32x4*)(P.out + (size_t)m * DM) + lane;
#pragma unroll
        for (int j = 0; j < 4; ++j) o0[64 * j] = v0[j] * rs0 * gv[j];
        if (m1 != m) {
            f32x4* o1 = (f32x4*)(P.out + (size_t)m1 * DM) + lane;
#pragma unroll
            for (int j = 0; j < 4; ++j) o1[64 * j] = v1[j] * rs1 * gv[j];
        }
    }
}

constexpr int LDS_RSL = 131072;
template <bool COLS> __device__ __forceinline__ void fill_rs(LAS float* rsl, const pg8::StaticOrder& S, const float* part) {
    int tid_ = threadIdx.x; asm volatile("" : "+v"(tid_));
    LAS int* ul = (LAS int*)(rsl + 14 * 256);
    if (tid_ < 16) { pg8::Unit u; int v = -1; if (tid_ < 14 && S.next(tid_, u)) v = COLS ? u.pn : u.pm; ul[tid_] = v; }
    __syncthreads();
    for (int idx = tid_; idx < 14 * 256; idx += 512) {
        const int p = ul[idx >> 8]; if (p < 0) break;
        rsl[idx] = pg8::rs_from_part(part, p * 256 + (idx & 255));
    }
    __syncthreads();
}

__global__ void __launch_bounds__(512, 2) fwd_kernel(Params P) {
    extern __shared__ __attribute__((aligned(16))) unsigned char lds_raw[];
    LAS unsigned char* lds = (LAS unsigned char*)lds_raw;
    cg::grid_group grid = cg::this_grid();
    unsigned char* ws = P.ws;
    const int G = gridDim.x, bx = blockIdx.x;
    bf16_t* XB = (bf16_t*)(ws + WS_XB); bf16_t* YB = (bf16_t*)(ws + WS_Y); bf16_t* HB = (bf16_t*)(ws + WS_H); bf16_t* VT = (bf16_t*)(ws + WS_VT);
    float* part = (float*)(ws + WS_PART); pg8::f32x2v* lns = (pg8::f32x2v*)(ws + WS_LNS);

    LAS unsigned* misc = (LAS unsigned*)(lds + LDS_CTL);
    if (threadIdx.x < 16) misc[threadIdx.x] = 0u;
    __syncthreads();
    prologue_phase(P, lds);
    grid.sync();
    const XcdBarrier xbar = xcd_barrier_post((unsigned*)(ws + WS_CTL) + CW_BAR, (volatile LAS unsigned*)(misc + 8));
#define GSYNC() xcd_barrier(xbar)

    for (int l = 0; l < 4; ++l) {
        const int e = l >> 1;
        if ((l & 1) == 0) {
            { const bf16_t* Wt = (const bf16_t*)(ws + WS_WIN) + (size_t)e * 2560 * 1024;
              { pg8::Gemm g{XB, Wt, MTOK, 2048, 1024}; pg8::StaticOrder S; S.init(MTOK, 2048, G, bx);
                fill_rs<false>((LAS float*)(lds + LDS_RSL), S, part);
                pg8::EpiScaleAct<0, false, 6> E{HB, PROJ_LD, (const LAS float*)(lds + LDS_RSL), lns};
                pg8::gemm_phase<pg8::EpiScaleAct<0, false, 6>, pg8::StaticOrder, true, true>(lds, g, S, E); }
              { pg8::Gemm g{Wt + (size_t)2048 * 1024, XB, 512, MTOK, 1024}; pg8::StaticOrder S; S.init(512, MTOK, G, bx);
                fill_rs<true>((LAS float*)(lds + LDS_RSL), S, part);
                pg8::EpiVT E{VT, MTOK, (const LAS float*)(lds + LDS_RSL)};
                pg8::gemm_phase<pg8::EpiVT, pg8::StaticOrder, true, true>(lds, g, S, E); } }
            GSYNC();
            if (l == 0 && threadIdx.x == 0) misc[12] = (((unsigned)G & 7u) == 0u && xb_ld(xbar.bar + XB_MISM) == 0u) ? 1u : 0u;
            { const float lam = ((const float*)(ws + WS_SMALL + SM_LAM))[e];
              const float lam_init = (e == 0) ? 0.2f : (0.8f - 0.6f * 0.54881163609f);
              LAS unsigned* bc = (LAS unsigned*)(lds + LDS_CTL);
              unsigned* qbase = (unsigned*)(ws + WS_CTL) + e * 8;
              for (int kq = 0; kq < 8; ++kq) {
                  const int xq = (bx + kq) & 7;
                  if (kq == 1) {
                      int t_ = threadIdx.x; asm volatile("" : "+v"(t_));
                      if (t_ >= 1 && t_ < 8) bc[t_] = __hip_atomic_load(qbase + ((bx + t_) & 7), __ATOMIC_RELAXED, __HIP_MEMORY_SCOPE_AGENT);
                      WG_BAR();
                  }
                  if (kq >= 1 && bc[kq] >= (unsigned)(8 + 128)) continue;
                  if (threadIdx.x == 0) bc[0] = atomicAdd(qbase + xq, 1u);
                  for (;;) {
                      WG_BAR();
                      const unsigned idx = bc[0];
                      WG_BAR();
                      if (idx >= (unsigned)(8 + 128)) break;
                      unsigned pre = 0u;
                      if (idx < 8u) { lru_unit(P, e, xq, (int)idx, lds); if (threadIdx.x == 0) pre = atomicAdd(qbase + xq, 1u); }
                      else { const int a = (int)idx - 8; const int qb = 31 - (a >> 2), h = a & 3;
                             attn_unit(HB, VT, YB, P.in[9] + e * 128, lam, 1.0f - lam_init, xq, h, qb, qbase + xq, pre, lds); }
                      if (threadIdx.x == 0) bc[0] = pre;
                  }
              } }
            GSYNC();
        } else {
            { const bf16_t* Wt = (const bf16_t*)(ws + WS_CIN) + (size_t)e * 2048 * 1024;
              pg8::Gemm g{XB, Wt, MTOK, 2048, 1024}; pg8::StaticOrder S; S.init(MTOK, 2048, G, bx);
              fill_rs<false>((LAS float*)(lds + LDS_RSL), S, part);
              pg8::EpiScaleAct<1, true> E{HB, PROJ_LD, (const LAS float*)(lds + LDS_RSL), lns};
              pg8::gemm_phase<pg8::EpiScaleAct<1, true>, pg8::StaticOrder, true, true>(lds, g, S, E); }
            GSYNC();
            for (int u = bx; u < 2048; u += G) sgu_unit(P, e, u, lds);
            GSYNC();
        }
        { const bf16_t* Wt = (l & 1) ? (const bf16_t*)(ws + WS_COUT) + (size_t)e * 1024 * 1024 : (const bf16_t*)(ws + WS_WOUT) + (size_t)e * 1024 * 1024;
          pg8::Gemm g{YB, Wt, MTOK, 1024, 1024}; pg8::StaticOrder S; S.init(MTOK, 1024, G, bx);
          pg8::EpiResid E{XB, part};
          pg8::gemm_phase<pg8::EpiResid, pg8::StaticOrder, true, true>(lds, g, S, E); }
        xcd_barrier(xbar, *(volatile LAS unsigned*)(misc + 12) != 0u);
        { const bf16_t* Wt = (const bf16_t*)(ws + WS_W1) + (size_t)l * 4096 * 1024;
          pg8::Gemm g{XB, Wt, MTOK, 4096, 1024}; pg8::StaticOrder S; S.init(MTOK, 4096, G, bx);
          fill_rs<false>((LAS float*)(lds + LDS_RSL), S, part);
          pg8::EpiScaleAct<2, false> E{HB, DFF, (const LAS float*)(lds + LDS_RSL), lns};
          pg8::gemm_phase<pg8::EpiScaleAct<2, false>, pg8::StaticOrder, true, true>(lds, g, S, E); }
        xcd_barrier(xbar, *(volatile LAS unsigned*)(misc + 12) != 0u);
        { const bf16_t* Wt = (const bf16_t*)(ws + WS_W2) + (size_t)l * 1024 * 4096;
          pg8::Gemm g{HB, Wt, MTOK, 1024, 4096}; pg8::StaticOrder S; S.init(MTOK, 1024, G, bx);
          pg8::EpiResid E{XB, part};
          pg8::gemm_phase<pg8::EpiResid, pg8::StaticOrder, true, true>(lds, g, S, E); }
        GSYNC();
    }
    final_norm_phase(P);
}

extern "C" void kernel_launch(void* const* d_in, const int* in_sizes, int n_in, void* d_out, int out_size, void* d_ws, size_t ws_size, hipStream_t stream) {
    static int grid = 0;
    if (grid == 0) {
        if (n_in != 26 || in_sizes[0] != MTOK * DM || out_size != MTOK * DM || ws_size < WS_END) {
            fprintf(stderr, "kernel_launch: unexpected shapes (n_in %d, in0 %d, out %d, ws %zu; need ws >= %zu); nothing launched\n", n_in, n_in > 0 ? in_sizes[0] : -1, out_size, ws_size, (size_t)WS_END);
            grid = -1; return; }
        int dev = 0, cus = 0, per_cu = 0;
        if (hipGetDevice(&dev) != hipSuccess || hipDeviceGetAttribute(&cus, hipDeviceAttributeMultiprocessorCount, dev) != hipSuccess) { fprintf(stderr, "kernel_launch: device query failed\n"); grid = -1; return; }
        if (hipFuncSetAttribute((const void*)fwd_kernel, hipFuncAttributeMaxDynamicSharedMemorySize, LDS_BYTES) != hipSuccess) { fprintf(stderr, "kernel_launch: hipFuncSetAttribute failed\n"); grid = -1; return; }
        if (hipOccupancyMaxActiveBlocksPerMultiprocessor(&per_cu, (const void*)fwd_kernel, 512, LDS_BYTES) != hipSuccess || per_cu < 1) { fprintf(stderr, "kernel_launch: occupancy query gave %d\n", per_cu); per_cu = 1; }
        (void)hipGetLastError();
        grid = cus * per_cu;
    }
    if (grid < 0) return;
    Params p{};
    for (int i = 0; i < 26; ++i) p.in[i] = (const float*)d_in[i];
    p.out = (float*)d_out; p.ws = (unsigned char*)d_ws;
    void* args[] = {&p};
    hipError_t err = hipLaunchCooperativeKernel((const void*)fwd_kernel, dim3(grid), dim3(512), args, LDS_BYTES, stream);
    if (err != hipSuccess) fprintf(stderr, "kernel_launch: cooperative launch failed: %s (grid %d)\n", hipGetErrorString(err), grid);
}
```

```cpp
#include <hip/hip_runtime.h>
#include <hip/hip_cooperative_groups.h>
#include <cstdio>
#include <cstdint>
namespace cg = cooperative_groups;
namespace pg8 {
#define PG8_LAS __attribute__((address_space(3)))
typedef unsigned short bf16_t;
typedef short bf16x8 __attribute__((ext_vector_type(8)));
typedef float f32x4 __attribute__((ext_vector_type(4)));
typedef unsigned u32x4 __attribute__((ext_vector_type(4)));
constexpr int BM = 256, BK = 64, HALF = 128, HTB = HALF * BK * 2  , STAGE_BYTES = 8 * HTB, NXCD = 8, WGM = 8;

__host__ __device__ __forceinline__ int lds_byte(int r, int c) { const int st = (r >> 4) * 2 + (c >> 5), rr = r & 15, cc = c & 31, ob = rr * 64 + cc * 2; return st * 1024 + (ob ^ (((ob >> 9) & 1) << 5)); }
__host__ __device__ __forceinline__ void stage_rc(int b, int& R, int& C) { const int st = b / 1024, sb = b % 1024, swz = sb ^ (((sb >> 9) & 1) << 5); R = (st >> 1) * 16 + swz / 64; C = (st & 1) * 32 + (swz % 64) / 2; }
__host__ __device__ __forceinline__ int perm32(int rho) { const int n = rho >> 4, i = rho & 15; return 8 * (i >> 2) + 4 * n + (i & 3); }

struct Unit { int pm, pn, ui; };
struct Gemm { const bf16_t* A; const bf16_t* Bt; int M, N, K; };

struct StaticOrder {
    int nM, nN, nwg, G, c;
    __host__ __device__ void init(int M, int N, int G_, int c_) { nM = M / BM; nN = N / BM; nwg = nM * nN; G = G_; c = c_; }
    __host__ __device__ bool next(int i, Unit& u) const {
        const long L = (long)i * G + c; if (L >= nwg) return false;
        int wgid = (int)L; { const int q = nwg / NXCD, r = nwg % NXCD, xcd = wgid % NXCD, off = wgid / NXCD; wgid = (xcd < r ? xcd * (q + 1) : r * (q + 1) + (xcd - r) * q) + off; }
        const int nig = WGM * nN, gid = wgid / nig, fm = gid * WGM, gsz = (nM - fm) < WGM ? (nM - fm) : WGM;
        u.pm = fm + ((wgid % nig) % gsz); u.pn = (wgid % nig) / gsz; u.ui = i; return true;
    }
    __device__ __forceinline__ void a_ready(const Unit&) const {}
    __device__ __forceinline__ void done(const Unit&) const {}
};

__device__ __forceinline__ unsigned cvt_pk_bf16(float lo, float hi) { unsigned r; asm volatile("v_cvt_pk_bf16_f32 %0, %1, %2" : "=v"(r) : "v"(lo), "v"(hi)); return r; }
typedef float f32x2v __attribute__((ext_vector_type(2)));
typedef unsigned u32x2v __attribute__((ext_vector_type(2)));
typedef __bf16 bf16x2_t __attribute__((ext_vector_type(2)));
__device__ __forceinline__ unsigned cvtpk(float lo, float hi) { f32x2v v = {lo, hi}; bf16x2_t b = __builtin_convertvector(v, bf16x2_t); return __builtin_bit_cast(unsigned, b); }
constexpr float RMS_EPS = 1e-6f;
__device__ __forceinline__ float gelu_tanh(float x) {
    const float u = x * (1.0f + 0.044715f * x * x);
    const float e = __builtin_amdgcn_exp2f(-2.302208198f * u);
    return x * __builtin_amdgcn_rcpf(1.0f + e);
}
__device__ __forceinline__ float rs_from_part(const float* part, int row) {
    const f32x4* pp = (const f32x4*)(part + (size_t)row * 16);
    const f32x4 a = pp[0], b = pp[1], c = pp[2], d = pp[3];
    const float s = ((a[0] + a[1]) + (a[2] + a[3])) + ((b[0] + b[1]) + (b[2] + b[3])) + ((c[0] + c[1]) + (c[2] + c[3])) + ((d[0] + d[1]) + (d[2] + d[3]));
    return rsqrtf(s * (1.0f / 1024.0f) + RMS_EPS);
}
template <int ACT, bool STATS, int GELU_PN = 99> struct EpiScaleAct {
    static constexpr bool PERM = true, AFTER_DRAIN = false;
    bf16_t* O; int ldc; const PG8_LAS float* rsl; f32x2v* lns;
    __device__ __forceinline__ void operator()(const f32x4 (&acc)[2][2][4][2], const Unit& u, int wr, int wc, int fr, int fq) const {
        const int row0 = u.pm * BM + wr * 64 + fr, col0 = u.pn * BM + wc * 32 + 8 * fq;
        float rs8[2][4];
#pragma unroll
        for (int ai = 0; ai < 2; ++ai)
#pragma unroll
            for (int m = 0; m < 4; ++m) rs8[ai][m] = rsl[u.ui * BM + wr * 64 + fr + ai * HALF + m * 16];
#pragma unroll
        for (int ai = 0; ai < 2; ++ai)
#pragma unroll
            for (int m = 0; m < 4; ++m) {
                const int row = row0 + ai * HALF + m * 16;
                const float rs = rs8[ai][m];
                bf16_t* rowp = O + (size_t)row * ldc + col0;
                float ssum = 0.f, ssq = 0.f;
#pragma unroll
                for (int bj = 0; bj < 2; ++bj) {
                    f32x4 v0 = acc[ai][bj][m][0] * rs, v1 = acc[ai][bj][m][1] * rs;
                    if (ACT == 1 || (GELU_PN < 99 && u.pn >= GELU_PN)) {
#pragma unroll
                        for (int e = 0; e < 4; ++e) { v0[e] = gelu_tanh(v0[e]); v1[e] = gelu_tanh(v1[e]); }
                    }
                    if (ACT == 2) {
#pragma unroll
                        for (int e = 0; e < 4; ++e) { const float a = fmaxf(v0[e], 0.f), b = fmaxf(v1[e], 0.f); v0[e] = a * a; v1[e] = b * b; }
                    }
                    if (STATS) {
#pragma unroll
                        for (int e = 0; e < 4; ++e) { ssum += v0[e] + v1[e]; ssq += v0[e] * v0[e] + v1[e] * v1[e]; }
                    }
                    u32x4 w; w.x = cvtpk(v0[0], v0[1]); w.y = cvtpk(v0[2], v0[3]); w.z = cvtpk(v1[0], v1[1]); w.w = cvtpk(v1[2], v1[3]);
                    if (ACT == 2) __builtin_nontemporal_store(w, (u32x4*)(rowp + bj * HALF));
                    else *(u32x4*)(rowp + bj * HALF) = w;
                }
                if (STATS) {
                    ssum += __shfl_xor(ssum, 16); ssum += __shfl_xor(ssum, 32);
                    ssq += __shfl_xor(ssq, 16); ssq += __shfl_xor(ssq, 32);
                    if (u.pn >= 4 && fq == 0) lns[(size_t)row * 16 + (u.pn - 4) * 4 + wc] = (f32x2v){ssum, ssq};
                }
            }
    }
};
struct EpiVT {
    static constexpr bool PERM = true, AFTER_DRAIN = false;
    bf16_t* O; int ldc; const PG8_LAS float* rsl;
    __device__ __forceinline__ void operator()(const f32x4 (&acc)[2][2][4][2], const Unit& u, int wr, int wc, int fr, int fq) const {
        const int row0 = u.pm * BM + wr * 64 + fr, col0 = u.pn * BM + wc * 32 + 8 * fq;
        f32x4 rsv[2][2];
#pragma unroll
        for (int bj = 0; bj < 2; ++bj)
#pragma unroll
            for (int n = 0; n < 2; ++n) rsv[bj][n] = *(const PG8_LAS f32x4*)(rsl + u.ui * BM + wc * 32 + 8 * fq + bj * HALF + 4 * n);
#pragma unroll
        for (int ai = 0; ai < 2; ++ai)
#pragma unroll
            for (int m = 0; m < 4; ++m) {
                const int row = row0 + ai * HALF + m * 16;
#pragma unroll
                for (int bj = 0; bj < 2; ++bj) {
                    const int tok = col0 + bj * HALF;
                    bf16_t* dst = O + ((((size_t)((tok >> 12) * 4 + (row >> 7)) * 64 + ((tok >> 6) & 63)) * 128 + (row & 127)) * 64 + (tok & 63));
                    const f32x4 v0 = acc[ai][bj][m][0] * rsv[bj][0], v1 = acc[ai][bj][m][1] * rsv[bj][1];
                    u32x4 w; w.x = cvtpk(v0[0], v0[1]); w.y = cvtpk(v0[2], v0[3]); w.z = cvtpk(v1[0], v1[1]); w.w = cvtpk(v1[2], v1[3]);
                    *(u32x4*)dst = w;
                }
            }
    }
};
struct EpiResid {
    static constexpr bool PERM = true, AFTER_DRAIN = false;
    bf16_t* xb; float* part;
    __device__ __forceinline__ void operator()(const f32x4 (&acc)[2][2][4][2], const Unit& u, int wr, int wc, int fr, int fq) const {
        const int row0 = u.pm * BM + wr * 64 + fr, col0 = u.pn * BM + wc * 32 + 8 * fq;
#pragma unroll
        for (int ai = 0; ai < 2; ++ai) {
            u32x4 old[4][2];
#pragma unroll
            for (int m = 0; m < 4; ++m)
#pragma unroll
                for (int bj = 0; bj < 2; ++bj) old[m][bj] = *(const u32x4*)(xb + (size_t)(row0 + ai * HALF + m * 16) * 1024 + col0 + bj * HALF);
            asm volatile("" ::: "memory");
#pragma unroll
            for (int m = 0; m < 4; ++m) {
                const int row = row0 + ai * HALF + m * 16;
                bf16_t* xp = xb + (size_t)row * 1024 + col0;
                float ss = 0.f;
#pragma unroll
                for (int bj = 0; bj < 2; ++bj) {
                    const u32x4 ov = old[m][bj];
                    f32x4 o0 = acc[ai][bj][m][0], o1 = acc[ai][bj][m][1];
                    o0[0] += __uint_as_float(ov.x << 16); o0[1] += __uint_as_float(ov.x & 0xffff0000u); o0[2] += __uint_as_float(ov.y << 16); o0[3] += __uint_as_float(ov.y & 0xffff0000u);
                    o1[0] += __uint_as_float(ov.z << 16); o1[1] += __uint_as_float(ov.z & 0xffff0000u); o1[2] += __uint_as_float(ov.w << 16); o1[3] += __uint_as_float(ov.w & 0xffff0000u);
                    ss += ((o0[0] * o0[0] + o0[1] * o0[1]) + (o0[2] * o0[2] + o0[3] * o0[3])) + ((o1[0] * o1[0] + o1[1] * o1[1]) + (o1[2] * o1[2] + o1[3] * o1[3]));
                    u32x4 w; w.x = cvtpk(o0[0], o0[1]); w.y = cvtpk(o0[2], o0[3]); w.z = cvtpk(o1[0], o1[1]); w.w = cvtpk(o1[2], o1[3]);
                    *(u32x4*)(xp + bj * HALF) = w;
                }
                ss += __shfl_xor(ss, 16); ss += __shfl_xor(ss, 32);
                if (fq == 0) part[(size_t)row * 16 + u.pn * 4 + wc] = ss;
            }
            asm volatile("" ::: "memory");
        }
    }
};
template <class Epi, class Sched, bool ALIGN_EPI = false, bool SP2 = false>
__device__ __forceinline__ void gemm_phase(PG8_LAS unsigned char* lds, const Gemm g, const Sched& S, const Epi& E) {
    int tid_ = threadIdx.x; asm volatile("" : "+v"(tid_));
    const int tid = tid_, wid = __builtin_amdgcn_readfirstlane(tid >> 6), lane = tid & 63, wr = wid >> 2, wc = wid & 3, fr = lane & 15, fq = lane >> 4;
    const int K = g.K, nt = K / BK;
    unsigned voffA[2], voffB[2];
#pragma unroll
    for (int i = 0; i < 2; ++i) { int R, C; stage_rc(tid * 16 + i * 8192, R, C); const int Rb = Epi::PERM ? ((R & ~31) + perm32(R & 31)) : R;
        voffA[i] = (unsigned)(R * K + C) * 2u; voffB[i] = (unsigned)(Rb * K + C) * 2u; }
    const size_t kstep = (size_t)(BK * 2);
    const size_t hstep = (size_t)HALF * K * 2;
    const size_t tstep = 2 * hstep;
    const unsigned ldsw = (unsigned)wid * 1024u;
    const int aoff = lds_byte(wr * 64 + fr, fq * 8), boff = lds_byte(wc * 32 + fr, fq * 8);
#define PG8_SA(b, h) (((b) * 2 + (h)) * HTB)
#define PG8_SB(b, h) ((4 + (b) * 2 + (h)) * HTB)
#define PG8_STAGE(bufoff, gbase, voff) do { _Pragma("unroll") for (int _i = 0; _i < 2; ++_i) \
        __builtin_amdgcn_global_load_lds((const unsigned*)((const char*)(gbase) + (voff)[_i]), (PG8_LAS unsigned*)(lds + (bufoff) + ldsw + _i * 8192), 16, 0, 0); } while (0)
#define PG8_LDA(dst, b, h) do { _Pragma("unroll") for (int m = 0; m < 4; ++m) _Pragma("unroll") for (int k = 0; k < 2; ++k) dst[m][k] = *(const PG8_LAS bf16x8*)(lds + PG8_SA(b, h) + aoff + m * 2048 + k * 1024); } while (0)
#define PG8_LDB(dst, b, h) do { _Pragma("unroll") for (int n = 0; n < 2; ++n) _Pragma("unroll") for (int k = 0; k < 2; ++k) dst[n][k] = *(const PG8_LAS bf16x8*)(lds + PG8_SB(b, h) + boff + n * 2048 + k * 1024); } while (0)
#define PG8_MMA(ai, bj, At, Bt) do { __builtin_amdgcn_s_setprio(1); _Pragma("unroll") for (int m = 0; m < 4; ++m) _Pragma("unroll") for (int n = 0; n < 2; ++n) _Pragma("unroll") for (int k = 0; k < 2; ++k) \
        acc[ai][bj][m][n] = __builtin_amdgcn_mfma_f32_16x16x32_bf16(Bt[n][k], At[m][k], acc[ai][bj][m][n], 0, 0, 0); __builtin_amdgcn_s_setprio(0); } while (0)
#define PG8_WAIT_V(n) asm volatile("s_waitcnt vmcnt(" #n ")" ::: "memory")
#define PG8_WAIT_L(n) asm volatile("s_waitcnt lgkmcnt(" #n ")" ::: "memory")
#define PG8_BAR __builtin_amdgcn_s_barrier()
#define PG8_SCHED __builtin_amdgcn_sched_barrier(0)
    Unit cur, nxt; int ui = 0;
    if (!S.next(0, cur)) return;
    f32x4 acc[2][2][4][2];
#pragma unroll
    for (int a = 0; a < 2; ++a)
#pragma unroll
        for (int b = 0; b < 2; ++b)
#pragma unroll
            for (int m = 0; m < 4; ++m)
#pragma unroll
                for (int n = 0; n < 2; ++n) acc[a][b][m][n] = (f32x4){0.f, 0.f, 0.f, 0.f};
    bf16x8 At[4][2], B0[2][2], B1[2][2];
    const char* cA = (const char*)g.A + (size_t)cur.pm * tstep; const char* cB = (const char*)g.Bt + (size_t)cur.pn * tstep;
    S.a_ready(cur);
    if constexpr (SP2) {
        PG8_STAGE(PG8_SB(0, 0), cB, voffB); PG8_STAGE(PG8_SB(0, 1), cB + hstep, voffB); PG8_STAGE(PG8_SA(0, 0), cA, voffA); PG8_STAGE(PG8_SA(0, 1), cA + hstep, voffA);
        if (wr == 1) PG8_BAR;
        PG8_WAIT_V(2); PG8_BAR;
        PG8_STAGE(PG8_SB(1, 0), cB + kstep, voffB); PG8_STAGE(PG8_SA(1, 0), cA + kstep, voffA); PG8_STAGE(PG8_SB(1, 1), cB + hstep + kstep, voffB);
        PG8_WAIT_V(6); PG8_BAR;
    } else {
        PG8_STAGE(PG8_SB(0, 0), cB, voffB); PG8_STAGE(PG8_SA(0, 0), cA, voffA); PG8_STAGE(PG8_SB(0, 1), cB + hstep, voffB); PG8_STAGE(PG8_SA(0, 1), cA + hstep, voffA);
        if (wr == 1) PG8_BAR;
        PG8_WAIT_V(4); PG8_BAR;
        PG8_STAGE(PG8_SB(1, 0), cB + kstep, voffB); PG8_STAGE(PG8_SA(1, 0), cA + kstep, voffA); PG8_STAGE(PG8_SB(1, 1), cB + hstep + kstep, voffB);
        PG8_WAIT_V(6); PG8_BAR;
    }
    for (;;) {
        const bool has_next = S.next(ui + 1, nxt);
        const char* nA = has_next ? (const char*)g.A + (size_t)nxt.pm * tstep : cA; const char* nB = has_next ? (const char*)g.Bt + (size_t)nxt.pn * tstep : cB;
        for (int t = 0; t < nt; t += 2) {
            const bool last = (t == nt - 2);
            const char* a1 = cA + (size_t)(t + 1) * kstep;
            const char* a2 = last ? nA : cA + (size_t)(t + 2) * kstep; const char* b2 = last ? nB : cB + (size_t)(t + 2) * kstep;
            const char* a3 = a2 + kstep; const char* b3 = b2 + kstep;
            if (last && has_next) S.a_ready(nxt);
            if constexpr (SP2) {
            PG8_LDB(B0, 0, 0); PG8_LDB(B1, 0, 1); PG8_SCHED; PG8_LDA(At, 0, 0); PG8_STAGE(PG8_SA(1, 1), a1 + hstep, voffA);
            PG8_WAIT_V(8); PG8_WAIT_L(0); PG8_BAR; PG8_MMA(0, 0, At, B0); PG8_MMA(0, 1, At, B1); PG8_BAR; PG8_SCHED;
            PG8_LDA(At, 0, 1); PG8_STAGE(PG8_SB(0, 0), b2, voffB); PG8_STAGE(PG8_SB(0, 1), b2 + hstep, voffB); PG8_STAGE(PG8_SA(0, 0), a2, voffA);
            PG8_WAIT_V(8); PG8_WAIT_L(0); PG8_BAR; PG8_MMA(1, 0, At, B0); PG8_MMA(1, 1, At, B1); PG8_BAR; PG8_SCHED;
            PG8_LDB(B0, 1, 0); PG8_LDB(B1, 1, 1); PG8_SCHED; PG8_LDA(At, 1, 0); PG8_STAGE(PG8_SA(0, 1), a2 + hstep, voffA);
            PG8_WAIT_V(8); PG8_WAIT_L(0); PG8_BAR; PG8_MMA(0, 0, At, B0); PG8_MMA(0, 1, At, B1); PG8_BAR; PG8_SCHED;
            PG8_LDA(At, 1, 1); PG8_STAGE(PG8_SB(1, 0), b3, voffB); PG8_STAGE(PG8_SB(1, 1), b3 + hstep, voffB); PG8_STAGE(PG8_SA(1, 0), a3, voffA);
            PG8_WAIT_V(8); PG8_WAIT_L(0); PG8_BAR; PG8_MMA(1, 0, At, B0); PG8_MMA(1, 1, At, B1); PG8_BAR; PG8_SCHED;
            } else {
            PG8_LDB(B0, 0, 0); PG8_SCHED; PG8_LDA(At, 0, 0); PG8_STAGE(PG8_SA(1, 1), a1 + hstep, voffA);
            PG8_WAIT_L(8); PG8_BAR; PG8_WAIT_L(0); PG8_MMA(0, 0, At, B0); PG8_BAR; PG8_SCHED;
            PG8_LDB(B1, 0, 1); PG8_STAGE(PG8_SB(0, 0), b2, voffB);
            PG8_BAR; PG8_WAIT_L(0); PG8_MMA(0, 1, At, B1); PG8_BAR;
            PG8_LDA(At, 0, 1); PG8_STAGE(PG8_SA(0, 0), a2, voffA);
            PG8_BAR; PG8_WAIT_L(0); PG8_MMA(1, 0, At, B0); PG8_BAR; PG8_SCHED;
            PG8_STAGE(PG8_SB(0, 1), b2 + hstep, voffB);
            PG8_WAIT_V(6); PG8_BAR; PG8_MMA(1, 1, At, B1); PG8_BAR;
            PG8_LDB(B0, 1, 0); PG8_SCHED; PG8_LDA(At, 1, 0); PG8_STAGE(PG8_SA(0, 1), a2 + hstep, voffA);
            PG8_WAIT_L(8); PG8_BAR; PG8_WAIT_L(0); PG8_MMA(0, 0, At, B0); PG8_BAR; PG8_SCHED;
            PG8_LDB(B1, 1, 1); PG8_STAGE(PG8_SB(1, 0), b3, voffB);
            PG8_BAR; PG8_WAIT_L(0); PG8_MMA(0, 1, At, B1); PG8_BAR;
            PG8_LDA(At, 1, 1); PG8_STAGE(PG8_SA(1, 0), a3, voffA);
            PG8_BAR; PG8_WAIT_L(0); PG8_MMA(1, 0, At, B0); PG8_BAR; PG8_SCHED;
            PG8_STAGE(PG8_SB(1, 1), b3 + hstep, voffB);
            PG8_WAIT_V(6); PG8_BAR; PG8_MMA(1, 1, At, B1); PG8_BAR;
            }
        }
        if constexpr (ALIGN_EPI) { if (wr == 0) PG8_BAR; }
        if constexpr (!Epi::AFTER_DRAIN) { E(acc, cur, wr, wc, fr, fq); S.done(cur); }
        if (!has_next) break;
#pragma unroll
        for (int a = 0; a < 2; ++a)
#pragma unroll
            for (int b = 0; b < 2; ++b)
#pragma unroll
                for (int m = 0; m < 4; ++m)
#pragma unroll
                    for (int n = 0; n < 2; ++n) acc[a][b][m][n] = (f32x4){0.f, 0.f, 0.f, 0.f};
        cur = nxt; cA = nA; cB = nB; ++ui;
        if constexpr (ALIGN_EPI) { if (wr == 1) PG8_BAR; }
    }
    PG8_WAIT_V(0);
    if constexpr (!ALIGN_EPI) { if (wr == 0) PG8_BAR; }
    PG8_BAR;
    if constexpr (Epi::AFTER_DRAIN) { E.fused(acc, cur, wr, wc, fr, fq, lds, wid, lane); S.done(cur); }
#undef PG8_SA
#undef PG8_SB
#undef PG8_STAGE
#undef PG8_LDA
#undef PG8_LDB
#undef PG8_MMA
#undef PG8_WAIT_V
#undef PG8_WAIT_L
#undef PG8_BAR
#undef PG8_SCHED
}
}
#define LAS __attribute__((address_space(3)))
typedef unsigned short bf16_t;
typedef short bf16x8 __attribute__((ext_vector_type(8)));
typedef float f32x4 __attribute__((ext_vector_type(4)));
typedef float f32x16 __attribute__((ext_vector_type(16)));
typedef unsigned u32x4 __attribute__((ext_vector_type(4)));
typedef unsigned u32x2 __attribute__((ext_vector_type(2)));
typedef float f32x2 __attribute__((ext_vector_type(2)));
using pg8::cvtpk; using pg8::gelu_tanh; using pg8::RMS_EPS;
constexpr int NB = 8, SEQ = 4096, DM = 1024, MTOK = NB * SEQ, DFF = 4096;
constexpr int PROJ_LD = 2048;
constexpr float QK_C2 = 0.125f * 1.4426950408889634f;
constexpr size_t MiB = 1u << 20;
constexpr size_t WS_CTL = 0;
constexpr size_t WS_PART = 1 * MiB;
constexpr size_t WS_LNS = 3 * MiB;
constexpr size_t WS_SMALL = 7 * MiB;
constexpr size_t SM_LRUW = 0;
constexpr size_t SM_WS = 256 * 1024;
constexpr size_t SM_LAM = 768 * 1024;
constexpr size_t WS_WIN = 8 * MiB;
constexpr size_t WS_WOUT = 18 * MiB;
constexpr size_t WS_CIN = 22 * MiB;
constexpr size_t WS_COUT = 30 * MiB;
constexpr size_t WS_W1 = 34 * MiB;
constexpr size_t WS_W2 = 66 * MiB;
constexpr size_t WS_XB = 98 * MiB;
constexpr size_t WS_Y = 162 * MiB;
constexpr size_t WS_H = 226 * MiB;
constexpr size_t WS_VT = WS_H + 128 * MiB;
constexpr size_t WS_END = 482 * MiB;
constexpr int LDS_BYTES = 147456;
constexpr int LDS_CTL = 146432;
constexpr int N_LRU_UNITS = 64, N_ATT_UNITS = NB * 4 * 32;

struct Params { const float* in[26]; float* out; unsigned char* ws; };

__device__ __forceinline__ float bf2f(unsigned short b) { return __uint_as_float((unsigned)b << 16); }
__device__ __forceinline__ float wave_sum(float v) {
#pragma unroll
    for (int o = 1; o < 64; o <<= 1) v += __shfl_xor(v, o);
    return v;
}
__device__ __forceinline__ float xhalf_max(float v) { auto rr = __builtin_amdgcn_permlane32_swap(__float_as_uint(v), __float_as_uint(v), false, false); return fmaxf(__uint_as_float(rr[0]), __uint_as_float(rr[1])); }
__device__ __forceinline__ float xhalf_sum(float v) { auto rr = __builtin_amdgcn_permlane32_swap(__float_as_uint(v), __float_as_uint(v), false, false); return __uint_as_float(rr[0]) + __uint_as_float(rr[1]); }
__device__ __forceinline__ float max3f(float a, float b, float c) { float r; asm("v_max3_f32 %0, %1, %2, %3" : "=v"(r) : "v"(a), "v"(b), "v"(c)); return r; }
__device__ __forceinline__ int crow(int i, int h) { return (i & 3) + 8 * (i >> 2) + 4 * h; }
#define MFMA32(a, b, c) __builtin_amdgcn_mfma_f32_32x32x16_bf16((a), (b), (c), 0, 0, 0)
#define WG_BAR() __syncthreads()

#define XB_TMO      128
#define XB_XCNT(j)  (256  + 64 * (j))
#define XB_XSUB(j)  (1280 + 64 * (j))
#define XB_XGEN(j)  (2304 + 64 * (j))
#define XB_TOP      3328
#define XB_TOPGEN   3392
#define XB_MISM     192
#define XB_LSUB(j)  (3456 + 64 * (j))
#define XB_LGEN(j)  (4480 + 64 * (j))
#define XB_GRP(j)   (5504 + 64 * (j))
#define XCD_BAR_WORDS 6016
#define XB_SPIN_CAP (1u << 23)

__device__ __forceinline__ unsigned xb_ld(unsigned* p)              { return __hip_atomic_load(p, __ATOMIC_RELAXED, __HIP_MEMORY_SCOPE_AGENT); }
__device__ __forceinline__ unsigned xb_add(unsigned* p, unsigned v) { return __hip_atomic_fetch_add(p, v, __ATOMIC_RELAXED, __HIP_MEMORY_SCOPE_AGENT); }
__device__ __forceinline__ unsigned xb_xcc_id() { return (unsigned)__builtin_amdgcn_s_getreg((3 << 11) | 20) & 0xFu; }
#define XB_SPIN(cond, bar) do { unsigned _sp = 0; while (cond) { __builtin_amdgcn_s_sleep(1); \
    if ((++_sp & 255u) == 0u) { if (xb_ld(&(bar)[XB_TMO])) break; if (_sp > XB_SPIN_CAP) { atomicAdd(&(bar)[XB_TMO], 1u); break; } } } } while (0)

struct XcdBarrier {
    unsigned* bar; unsigned x;
    volatile LAS unsigned* st;
};

__device__ __forceinline__ XcdBarrier xcd_barrier_post(unsigned* bar, volatile LAS unsigned* st) {
    XcdBarrier b; b.bar = bar; b.x = xb_xcc_id(); b.st = st;
    if (threadIdx.x == 0) {
        (void)__hip_atomic_fetch_max(&bar[XB_GRP(blockIdx.x & 7u)], b.x + 1u, __ATOMIC_RELAXED, __HIP_MEMORY_SCOPE_AGENT);
        (void)__hip_atomic_fetch_max(&bar[XB_GRP(blockIdx.x & 7u) + 16], 8u - (b.x & 7u), __ATOMIC_RELAXED, __HIP_MEMORY_SCOPE_AGENT);
        asm volatile("s_waitcnt vmcnt(0)" ::: "memory");
        (void)xb_add(&bar[XB_XCNT(b.x)], 1u);
    }
    return b;
}
__device__ __forceinline__ void xcd_barrier_complete(unsigned* bar, unsigned x, unsigned& nloc, unsigned& nx) {
    const unsigned G = gridDim.x * gridDim.y * gridDim.z;
    unsigned sum, cnt, mine, sp = 0u;
    for (;;) {
        sum = 0u; cnt = 0u; mine = 0u;
#pragma unroll
        for (unsigned j = 0; j < 16; ++j) { const unsigned c = xb_ld(&bar[XB_XCNT(j)]); sum += c; cnt += (c > 0u) ? 1u : 0u; mine = (j == x) ? c : mine; }
        if (sum == G) break;
        __builtin_amdgcn_s_sleep(1);
        if ((++sp & 255u) == 0u) { if (xb_ld(&bar[XB_TMO])) break; if (sp > XB_SPIN_CAP) { atomicAdd(&bar[XB_TMO], 1u); break; } }
    }
    nloc = mine > 0u ? mine : 1u; nx = cnt > 0u ? cnt : 1u;
}

__device__ __forceinline__ void xcd_barrier(const XcdBarrier& b, bool local = false) {
    asm volatile("s_waitcnt vmcnt(0)" ::: "memory");
    __syncthreads();
    if (threadIdx.x == 0) {
        unsigned* bar = b.bar;
        __builtin_amdgcn_s_waitcnt(0);
        unsigned nloc = b.st[0], nx = b.st[1];
        if (nloc == 0u) { xcd_barrier_complete(bar, b.x, nloc, nx); b.st[0] = nloc; b.st[1] = nx; }
        unsigned xx = b.x; asm volatile("" : "+s"(xx));
        const unsigned old = xb_add(&bar[XB_XSUB(xx)], 1u);
        const unsigned gen = old / nloc;
        if (old + 1u == (gen + 1u) * nloc) {
          if (!local) {
            __builtin_amdgcn_fence(__ATOMIC_RELEASE, "agent");
            asm volatile("s_waitcnt vmcnt(0)" ::: "memory");
            const unsigned og = xb_add(&bar[XB_TOP], 1u);
            const unsigned tg = og / nx;
            if (og + 1u == (tg + 1u) * nx) xb_add(&bar[XB_TOPGEN], 1u);
            else XB_SPIN(xb_ld(&bar[XB_TOPGEN]) == tg, bar);
          }
            __builtin_amdgcn_fence(__ATOMIC_ACQUIRE, "agent");
            xb_add(&bar[XB_XGEN(xx)], 1u);
            asm volatile("s_waitcnt vmcnt(0)" ::: "memory");
        } else {
            XB_SPIN(xb_ld(&bar[XB_XGEN(xx)]) == gen, bar);
            __builtin_amdgcn_fence(__ATOMIC_ACQUIRE, "agent");
            asm volatile("s_waitcnt vmcnt(0)" ::: "memory");
        }
    }
    __syncthreads();
}

constexpr int CW_BAR = 16384;

struct P0Item { const float* W; bf16_t* WT; const float* gain; int K, N, k0, n0, r0; float cs; };
__device__ __forceinline__ P0Item p0_decode(const Params& P, unsigned char* ws, int it) {
    constexpr int I_WIN = 16 * 80, I_WOUT = 16 * 32, I_CIN = 16 * 64, I_COUT = 16 * 32, I_W1 = 16 * 128, I_W2 = 64 * 32;
    constexpr int T0 = 2 * I_WIN, T1 = T0 + 2 * I_WOUT, T2 = T1 + 2 * I_CIN, T3 = T2 + 2 * I_COUT, T4 = T3 + 4 * I_W1;
    P0Item d; int mode = 0, item;
    if (it < T0) { const int e = it / I_WIN; item = it % I_WIN; d.W = P.in[4] + (size_t)e * 1024 * 2560; d.K = 1024; d.N = 2560; d.WT = (bf16_t*)(ws + WS_WIN) + (size_t)e * 2560 * 1024; d.gain = P.in[1] + (2 * e) * 1024; mode = 1; }
    else if (it < T1) { const int e = (it - T0) / I_WOUT; item = (it - T0) % I_WOUT; d.W = P.in[17] + (size_t)e * 1024 * 1024; d.K = 1024; d.N = 1024; d.WT = (bf16_t*)(ws + WS_WOUT) + (size_t)e * 1024 * 1024; d.gain = nullptr; }
    else if (it < T2) { const int o = (it - T1) / I_CIN; item = (it - T1) % I_CIN; d.W = P.in[18] + (size_t)o * 1024 * 2048; d.K = 1024; d.N = 2048; d.WT = (bf16_t*)(ws + WS_CIN) + (size_t)o * 2048 * 1024; d.gain = P.in[1] + (2 * o + 1) * 1024; }
    else if (it < T3) { const int o = (it - T2) / I_COUT; item = (it - T2) % I_COUT; d.W = P.in[23] + (size_t)o * 1024 * 1024; d.K = 1024; d.N = 1024; d.WT = (bf16_t*)(ws + WS_COUT) + (size_t)o * 1024 * 1024; d.gain = nullptr; }
    else if (it < T4) { const int l = (it - T3) / I_W1; item = (it - T3) % I_W1; d.W = P.in[24] + (size_t)l * 1024 * 4096; d.K = 1024; d.N = 4096; d.WT = (bf16_t*)(ws + WS_W1) + (size_t)l * 4096 * 1024; d.gain = P.in[2] + l * 1024; }
    else { const int l = (it - T4) / I_W2; item = (it - T4) % I_W2; d.W = P.in[25] + (size_t)l * 4096 * 1024; d.K = 4096; d.N = 1024; d.WT = (bf16_t*)(ws + WS_W2) + (size_t)l * 1024 * 4096; d.gain = nullptr; }
    const int nblk = d.N / 32, kb = item / nblk, nb = item % nblk; d.k0 = 64 * kb; d.n0 = 32 * nb; d.cs = 1.0f; d.r0 = d.n0;
    if (mode == 1) { if (d.n0 < 512) d.cs = QK_C2; d.r0 = (d.n0 < 1024) ? d.n0 : ((d.n0 < 1536) ? d.n0 + 1024 : d.n0 - 512); }
    return d;
}
__device__ __forceinline__ void p0_load(const P0Item& d, int lane, f32x4 (&v)[8], float (&g)[8]) {
#pragma unroll
    for (int i = 0; i < 8; ++i) { const int kk = 8 * i + (lane >> 3), c4 = lane & 7;
        v[i] = __builtin_nontemporal_load((const f32x4*)(d.W + (size_t)(d.k0 + kk) * d.N + d.n0 + 4 * c4));
        g[i] = d.gain ? d.gain[d.k0 + kk] * d.cs : d.cs; }
}
__device__ __forceinline__ void p0_store(const P0Item& d, int lane, const f32x4 (&v)[8], const float (&g)[8], LAS float* scr) {
#pragma unroll
    for (int i = 0; i < 8; ++i) { const int kk = 8 * i + (lane >> 3), c4 = lane & 7;
        scr[kk * 33 + 4 * c4 + 0] = v[i][0] * g[i]; scr[kk * 33 + 4 * c4 + 1] = v[i][1] * g[i]; scr[kk * 33 + 4 * c4 + 2] = v[i][2] * g[i]; scr[kk * 33 + 4 * c4 + 3] = v[i][3] * g[i]; }
    asm volatile("s_waitcnt lgkmcnt(0)" ::: "memory");
    const int c = lane & 7;
#pragma unroll
    for (int j = 0; j < 4; ++j) { const int n = (lane >> 3) + 8 * j; const LAS float* s = scr + (8 * c) * 33 + n;
        u32x4 o; o.x = cvtpk(s[0 * 33], s[1 * 33]); o.y = cvtpk(s[2 * 33], s[3 * 33]); o.z = cvtpk(s[4 * 33], s[5 * 33]); o.w = cvtpk(s[6 * 33], s[7 * 33]);
        __builtin_nontemporal_store(o, (u32x4*)(d.WT + (size_t)(d.r0 + n) * d.K + d.k0 + 8 * c)); }
    asm volatile("s_waitcnt lgkmcnt(0)" ::: "memory");
}
__device__ __forceinline__ void prologue_phase(const Params& P, LAS unsigned char* lds) {
    int tid_ = threadIdx.x; asm volatile("" : "+v"(tid_));
    const int tid = tid_, lane = tid & 63, wave = tid >> 6;
    const int gw = blockIdx.x * 8 + wave, NGW = gridDim.x * 8;
    const int gt = blockIdx.x * 512 + tid, NGT = gridDim.x * 512;
    unsigned char* ws = P.ws;
    if (gt < 64) ((unsigned*)(ws + WS_CTL))[gt] = 0u;
    if (gt < XCD_BAR_WORDS) ((unsigned*)(ws + WS_CTL))[CW_BAR + gt] = 0u;
    if (blockIdx.x == 0 && wave < 2) {
        const int e = wave;
        const float a = wave_sum(P.in[5][e * 64 + lane] * P.in[6][e * 64 + lane]);
        const float b = wave_sum(P.in[7][e * 64 + lane] * P.in[8][e * 64 + lane]);
        const float lam_init = (e == 0) ? 0.2f : (0.8f - 0.6f * 0.54881163609f);
        if (lane == 0) ((float*)(ws + WS_SMALL + SM_LAM))[e] = expf(a) - expf(b) + lam_init;
    }
    {
        bf16_t* dst = (bf16_t*)(ws + WS_SMALL + SM_LRUW);
        for (int t = gt; t < 2 * 2 * 8 * 4096; t += NGT) {
            const int i = t & 63, j = (t >> 6) & 63, h = (t >> 12) & 7, mat = (t >> 15) & 1, e = t >> 16;
            const float v = P.in[mat ? 14 : 12][((size_t)(e * 8 + h) * 64 + i) * 64 + j];
            dst[t] = (bf16_t)(cvtpk(v * -1.4426950408889634f, 0.f) & 0xffffu);
        }
    }
    {
        bf16_t* dst = (bf16_t*)(ws + WS_SMALL + SM_WS);
        for (int t = gt; t < 2 * 8 * 128 * 128; t += NGT) {
            const int q = t & 127, p = (t >> 7) & 127;
            const float v = ((q >> 6) <= (p >> 6)) ? P.in[21][t] : 0.f;
            dst[t] = (bf16_t)(cvtpk(v, 0.f) & 0xffffu);
        }
    }
    {
        LAS float* scr = (LAS float*)(lds + wave * 16384);
        constexpr int NITEMS = 2 * 16 * 80 + 2 * 16 * 32 + 2 * 16 * 64 + 2 * 16 * 32 + 4 * 16 * 128 + 4 * 64 * 32;
        int it = gw; P0Item d; f32x4 v[8]; float g[8];
        if (it < NITEMS) { d = p0_decode(P, ws, it); p0_load(d, lane, v, g); }
        while (it < NITEMS) {
            const int itn = it + NGW; P0Item dn = d; f32x4 vn[8]; float gn[8];
#pragma unroll
            for (int i = 0; i < 8; ++i) { vn[i] = v[i]; gn[i] = g[i]; }
            if (itn < NITEMS) { dn = p0_decode(P, ws, itn); p0_load(dn, lane, vn, gn); }
            p0_store(d, lane, v, g, scr);
            d = dn; it = itn;
#pragma unroll
            for (int i = 0; i < 8; ++i) { v[i] = vn[i]; g[i] = gn[i]; }
        }
    }
    {
        const float* x = P.in[0]; bf16_t* xb = (bf16_t*)(ws + WS_XB); float* part = (float*)(ws + WS_PART);
        for (int m = gw; m < MTOK; m += 2 * NGW) {
            const int m1 = m + NGW;
            const bool two = m1 < MTOK;
            const f32x4* xr0 = (const f32x4*)(x + (size_t)m * DM) + lane;
            const f32x4* xr1 = (const f32x4*)(x + (size_t)(two ? m1 : m) * DM) + lane;
            f32x4 v0[4], v1[4]; float s0 = 0.f, s1 = 0.f;
#pragma unroll
            for (int j = 0; j < 4; ++j) { v0[j] = __builtin_nontemporal_load(xr0 + 64 * j); v1[j] = __builtin_nontemporal_load(xr1 + 64 * j); }
#pragma unroll
            for (int j = 0; j < 4; ++j) { s0 += (v0[j][0] * v0[j][0] + v0[j][1] * v0[j][1]) + (v0[j][2] * v0[j][2] + v0[j][3] * v0[j][3]);
                                          s1 += (v1[j][0] * v1[j][0] + v1[j][1] * v1[j][1]) + (v1[j][2] * v1[j][2] + v1[j][3] * v1[j][3]); }
            s0 = wave_sum(s0); s1 = wave_sum(s1);
            u32x2* o0 = (u32x2*)(xb + (size_t)m * DM) + lane;
#pragma unroll
            for (int j = 0; j < 4; ++j) { u32x2 w; w.x = cvtpk(v0[j][0], v0[j][1]); w.y = cvtpk(v0[j][2], v0[j][3]); o0[64 * j] = w; }
            if (lane < 16) part[(size_t)m * 16 + lane] = s0 * (1.0f / 16.0f);
            if (two) {
                u32x2* o1 = (u32x2*)(xb + (size_t)m1 * DM) + lane;
#pragma unroll
                for (int j = 0; j < 4; ++j) { u32x2 w; w.x = cvtpk(v1[j][0], v1[j][1]); w.y = cvtpk(v1[j][2], v1[j][3]); o1[64 * j] = w; }
                if (lane < 16) part[(size_t)m1 * 16 + lane] = s1 * (1.0f / 16.0f);
            }
        }
    }
}

constexpr int AT_KS = 272, AT_VS = 144, AT_KBYTES = 64 * AT_KS, AT_VBYTES = 128 * AT_VS, AT_BUF = AT_KBYTES + AT_VBYTES;
__device__ __forceinline__ void attn_unit(const bf16_t* __restrict__ proj, const bf16_t* __restrict__ vt, bf16_t* __restrict__ Y, const float* __restrict__ subln, float lam, float out_scale,
                                          int b, int h, int qb, unsigned* qnext, unsigned& pre, LAS unsigned char* lds) {
    int tid_ = threadIdx.x; asm volatile("" : "+v"(tid_));
    const int tid = tid_, lane = tid & 63, w = __builtin_amdgcn_readfirstlane(tid >> 6), r = lane & 31, hh = lane >> 5;
    const int mp = w & 1, jg = w >> 1;
    const size_t rowbase = (size_t)b * SEQ;
    const int NT = 2 * qb + 2, cw = 2 * qb + (jg >> 1);
    bf16x8 qf[4];
    { const bf16_t* qp = proj + (rowbase + qb * 128 + jg * 32 + r) * PROJ_LD + h * 128 + mp * 64 + hh * 8;
#pragma unroll
      for (int ks = 0; ks < 4; ++ks) qf[ks] = *(const bf16x8*)(qp + ks * 16); }
    const char* kgb = (const char*)(proj + rowbase * PROJ_LD + 512 + h * 128);
    const char* vgb = (const char*)(vt + (size_t)(b * 4 + h) * 64 * 128 * 64);
    unsigned kg[2], vg[2]; int kl[2], vl[2];
#pragma unroll
    for (int i = 0; i < 2; ++i) { const int c = tid + 512 * i;
        kg[i] = (unsigned)((c >> 4) * PROJ_LD + (c & 15) * 8) * 2u; kl[i] = (c >> 4) * AT_KS + (c & 15) * 16;
        vg[i] = (unsigned)((c >> 3) * 64 + (c & 7) * 8) * 2u; vl[i] = AT_KBYTES + (c >> 3) * AT_VS + (c & 7) * 16; }
    const int pir = (r & 3) + 4 * ((r >> 3) & 1) + 8 * ((r >> 2) & 1) + 16 * (r >> 4);
    const int kbase = pir * AT_KS + mp * 128 + hh * 16, vbase = AT_KBYTES + r * AT_VS + hh * 16;
    u32x4 kreg[2], vreg[2];
#pragma unroll
    for (int i = 0; i < 2; ++i) { kreg[i] = *(const u32x4*)(kgb + kg[i]); vreg[i] = *(const u32x4*)(vgb + vg[i]); }
#pragma unroll
    for (int i = 0; i < 2; ++i) { *(LAS u32x4*)(lds + kl[i]) = kreg[i]; *(LAS u32x4*)(lds + vl[i]) = vreg[i]; }
    WG_BAR();
    float m_run = 0.f, l_run = 0.f;
    asm volatile("" : "+v"(m_run));
    f32x16 o[4];
#pragma unroll
    for (int nb = 0; nb < 4; ++nb)
#pragma unroll
        for (int i = 0; i < 16; ++i) o[nb][i] = 0.f;
    for (int t = 0; t < NT; ++t) {
        const int boff = (t & 1) * AT_BUF, noff = ((t + 1) & 1) * AT_BUF;
        const bool more = (t + 1 < NT);
        if (more) {
#pragma unroll
            for (int i = 0; i < 2; ++i) { kreg[i] = *(const u32x4*)(kgb + (kg[i] + (unsigned)(t + 1) * (64u * PROJ_LD * 2u))); vreg[i] = *(const u32x4*)(vgb + (vg[i] + (unsigned)(t + 1) * 16384u)); }
        }
        if (t <= cw) {
            f32x16 s0, s1;
#pragma unroll
            for (int i = 0; i < 16; ++i) { s0[i] = 0.f; s1[i] = 0.f; }
            const LAS unsigned char* kb = lds + boff + kbase;
            const LAS unsigned char* vb = lds + boff + vbase;
            bf16x8 kf0[4], kf1[4];
#pragma unroll
            for (int ks = 0; ks < 4; ++ks) { kf0[ks] = *(const LAS bf16x8*)(kb + ks * 32); kf1[ks] = *(const LAS bf16x8*)(kb + 32 * AT_KS + ks * 32); }
            __builtin_amdgcn_sched_barrier(0);
#pragma unroll
            for (int ks = 0; ks < 4; ++ks) { s0 = MFMA32(kf0[ks], qf[ks], s0); s1 = MFMA32(kf1[ks], qf[ks], s1); }
            bf16x8 vf[16];
#pragma unroll
            for (int nb = 0; nb < 4; ++nb)
#pragma unroll
                for (int kk = 0; kk < 4; ++kk) vf[nb * 4 + kk] = *(const LAS bf16x8*)(vb + nb * 32 * AT_VS + kk * 32);
            __builtin_amdgcn_sched_barrier(0);
#pragma unroll
            for (int i = 0; i < 16; ++i) { s0[i] -= m_run; s1[i] -= m_run; }
            float mxa = max3f(s0[0], s0[1], s0[2]), mxb = max3f(s1[0], s1[1], s1[2]);
#pragma unroll
            for (int i = 3; i < 15; i += 2) { mxa = max3f(mxa, s0[i], s0[i + 1]); mxb = max3f(mxb, s1[i], s1[i + 1]); }
            float mx = max3f(mxa, mxb, s0[15]); mx = max3f(mx, s1[15], s1[15]);
            mx = xhalf_max(mx);
            const bool upd = (t == 0) || (mx > 8.0f);
            if (__any(upd)) {
                const float dl = upd ? mx : 0.f;
                m_run += dl;
#pragma unroll
                for (int i = 0; i < 16; ++i) { s0[i] -= dl; s1[i] -= dl; }
                if (t != 0) {
                    const float alpha = __builtin_amdgcn_exp2f(-dl);
                    l_run *= alpha;
#pragma unroll
                    for (int nb = 0; nb < 4; ++nb)
#pragma unroll
                        for (int i = 0; i < 16; ++i) o[nb][i] *= alpha;
                }
            }
            float ps = 0.f;
            bf16x8 pf[4];
#define AT_EXPQ(S, B, K) do { _Pragma("unroll") for (int i_ = 0; i_ < 8; ++i_) { S[(B) + i_] = __builtin_amdgcn_exp2f(S[(B) + i_]); ps += S[(B) + i_]; } \
              u32x4 a_; a_.x = cvtpk(S[(B) + 0], S[(B) + 1]); a_.y = cvtpk(S[(B) + 2], S[(B) + 3]); a_.z = cvtpk(S[(B) + 4], S[(B) + 5]); a_.w = cvtpk(S[(B) + 6], S[(B) + 7]); pf[K] = __builtin_bit_cast(bf16x8, a_); } while (0)
#define AT_PVQ(K) do { _Pragma("unroll") for (int nb_ = 0; nb_ < 4; ++nb_) o[nb_] = MFMA32(vf[nb_ * 4 + (K)], pf[K], o[nb_]); } while (0)
#define AT_MIX() do { _Pragma("unroll") for (int g_ = 0; g_ < 4; ++g_) { __builtin_amdgcn_sched_group_barrier(0x008, 1, 0); __builtin_amdgcn_sched_group_barrier(0x402, 7, 0); } __builtin_amdgcn_sched_barrier(0); } while (0)
            AT_EXPQ(s0, 0, 0);
            __builtin_amdgcn_sched_barrier(0);
            AT_PVQ(0); AT_EXPQ(s0, 8, 1); AT_MIX();
            AT_PVQ(1); AT_EXPQ(s1, 0, 2); AT_MIX();
            AT_PVQ(2); AT_EXPQ(s1, 8, 3); AT_MIX();
            AT_PVQ(3);
#undef AT_EXPQ
#undef AT_PVQ
#undef AT_MIX
            l_run += ps;
        }
        if (more) {
#pragma unroll
            for (int i = 0; i < 2; ++i) { *(LAS u32x4*)(lds + noff + kl[i]) = kreg[i]; *(LAS u32x4*)(lds + noff + vl[i]) = vreg[i]; }
        }
        WG_BAR();
    }
    if (tid == 0) pre = atomicAdd(qnext, 1u);
    const float l_tot = xhalf_sum(l_run);
    const float inv = 1.0f / l_tot;
    LAS float* ex = (LAS float*)lds + jg * 4096;
    if (mp == 1) {
        const float sc = lam * inv;
#pragma unroll
        for (int nb = 0; nb < 4; ++nb)
#pragma unroll
            for (int i = 0; i < 16; ++i) ex[(nb * 16 + i) * 64 + lane] = o[nb][i] * sc;
    }
    WG_BAR();
    if (mp == 0) {
        float ss = 0.f;
#pragma unroll
        for (int nb = 0; nb < 4; ++nb)
#pragma unroll
            for (int i = 0; i < 16; ++i) { const float d = o[nb][i] * inv - ex[(nb * 16 + i) * 64 + lane]; o[nb][i] = d; ss += d * d; }
        ss = xhalf_sum(ss);
        const float rstd = rsqrtf(ss * (1.0f / 128.0f) + RMS_EPS) * out_scale;
        bf16_t* yp = Y + (rowbase + qb * 128 + jg * 32 + r) * DM + h * 128 + 4 * hh;
#pragma unroll
        for (int nb = 0; nb < 4; ++nb)
#pragma unroll
            for (int g4 = 0; g4 < 4; ++g4) {
                const int n0 = 32 * nb + 8 * g4;
                const f32x4 gg = *(const f32x4*)(subln + n0 + 4 * hh);
                u32x2 wv; wv.x = cvtpk(o[nb][4 * g4 + 0] * rstd * gg[0], o[nb][4 * g4 + 1] * rstd * gg[1]); wv.y = cvtpk(o[nb][4 * g4 + 2] * rstd * gg[2], o[nb][4 * g4 + 3] * rstd * gg[3]);
                *(u32x2*)(yp + n0) = wv;
            }
    }
    WG_BAR();
}

constexpr int LR_XS = 68;
constexpr int LR_WAVE_BYTES = 32 * LR_XS * 4 + 32 * 64 * 4;
constexpr int LR_CW_OFF = 8 * LR_WAVE_BYTES;
typedef short s16x2_t __attribute__((ext_vector_type(2)));
__device__ __forceinline__ float ldbf(const char* p) { s16x2_t t = {0, *(const short*)p}; return __builtin_bit_cast(float, t); }
__device__ __forceinline__ float sigmoidf_(float x) { return __builtin_amdgcn_rcpf(1.0f + __builtin_amdgcn_exp2f(-1.4426950408889634f * x)); }
__device__ __forceinline__ void lru_unit(const Params& P, int e, int b, int hd, LAS unsigned char* lds) {
    int tid_ = threadIdx.x; asm volatile("" : "+v"(tid_));
    const int tid = tid_, lane = tid & 63, w = __builtin_amdgcn_readfirstlane(tid >> 6), r = lane & 31, hh = lane >> 5;
    const bf16_t* proj = (const bf16_t*)(P.ws + WS_H); bf16_t* Y = (bf16_t*)(P.ws + WS_Y);
    const size_t rowbase = (size_t)b * SEQ;
    const int chg = hd * 64 + lane;
    bf16x8 waf[2][4], wxf[2][4];
    { const bf16_t* wt = (const bf16_t*)(P.ws + WS_SMALL + SM_LRUW) + (size_t)e * 2 * 8 * 4096;
#pragma unroll
      for (int nt = 0; nt < 2; ++nt)
#pragma unroll
          for (int ks = 0; ks < 4; ++ks) {
              waf[nt][ks] = *(const bf16x8*)(wt + (size_t)(0 * 8 + hd) * 4096 + (32 * nt + r) * 64 + 16 * ks + 8 * hh);
              wxf[nt][ks] = *(const bf16x8*)(wt + (size_t)(1 * 8 + hd) * 4096 + (32 * nt + r) * 64 + 16 * ks + 8 * hh);
          } }
    float ba_[2], bx_[2], c8_[2];
#pragma unroll
    for (int nt = 0; nt < 2; ++nt) { const int c = e * 512 + hd * 64 + 32 * nt + r; ba_[nt] = -1.4426950408889634f * P.in[13][c]; bx_[nt] = -1.4426950408889634f * P.in[15][c];
        c8_[nt] = -8.0f * 1.4426950408889634f * log1pf(expf(-P.in[16][c])); }
    const float cw0 = P.in[10][(e * 4 + 0) * 512 + chg], cw1 = P.in[10][(e * 4 + 1) * 512 + chg], cw2 = P.in[10][(e * 4 + 2) * 512 + chg], cw3 = P.in[10][(e * 4 + 3) * 512 + chg];
    const float cb = P.in[11][e * 512 + chg];
    LAS float* xs = (LAS float*)(lds + w * LR_WAVE_BYTES);
    LAS float* bs = (LAS float*)(lds + w * LR_WAVE_BYTES + 32 * LR_XS * 4);
    LAS f32x2* cwl = (LAS f32x2*)(lds + LR_CW_OFF);
    float carry = 0.f;
    const bf16_t* xblk = proj + rowbase * PROJ_LD + 1024 + hd * 64;
    const bf16_t* gblk = proj + rowbase * PROJ_LD + 1536 + hd * 64;
    bf16_t* yblk = Y + rowbase * DM + 512 + hd * 64;
    float xr[35];
    const char* xbase = (const char*)xblk; const char* gbase = (const char*)gblk; char* ybase = (char*)yblk;
    { const unsigned xo = (unsigned)(w * 32) * (PROJ_LD * 2) + lane * 2;
#pragma unroll
      for (int j = 0; j < 3; ++j) xr[j] = 0.f;
      if (w > 0) {
#pragma unroll
          for (int j = 0; j < 3; ++j) xr[j] = ldbf(xbase + (xo - (unsigned)(3 - j) * (PROJ_LD * 2)));
      }
#pragma unroll
      for (int pp = 0; pp < 32; ++pp) xr[3 + pp] = ldbf(xbase + (xo + (unsigned)pp * (PROJ_LD * 2))); }
    for (int tile = 0; tile < SEQ / 256; ++tile) {
        const int p0 = tile * 256 + w * 32;
        {
            float xm3 = xr[0], xm2 = xr[1], xm1 = xr[2];
#pragma unroll
            for (int pp = 0; pp < 32; ++pp) {
                const float x0 = xr[3 + pp];
                xs[pp * LR_XS + lane] = cb + cw0 * xm3 + cw1 * xm2 + cw2 * xm1 + cw3 * x0;
                xm3 = xm2; xm2 = xm1; xm1 = x0;
            }
        }
        f32x16 ga[2], gx[2];
#pragma unroll
        for (int nt = 0; nt < 2; ++nt)
#pragma unroll
            for (int i = 0; i < 16; ++i) { ga[nt][i] = 0.f; gx[nt][i] = 0.f; }
#pragma unroll
        for (int ks = 0; ks < 4; ++ks) {
            const f32x4 a0 = *(const LAS f32x4*)(xs + r * LR_XS + 16 * ks + 8 * hh), a1 = *(const LAS f32x4*)(xs + r * LR_XS + 16 * ks + 8 * hh + 4);
            u32x4 pk; pk.x = cvtpk(a0[0], a0[1]); pk.y = cvtpk(a0[2], a0[3]); pk.z = cvtpk(a1[0], a1[1]); pk.w = cvtpk(a1[2], a1[3]);
            const bf16x8 af = __builtin_bit_cast(bf16x8, pk);
#pragma unroll
            for (int nt = 0; nt < 2; ++nt) { ga[nt] = MFMA32(af, waf[nt][ks], ga[nt]); gx[nt] = MFMA32(af, wxf[nt][ks], gx[nt]); }
        }
#pragma unroll
        for (int nt = 0; nt < 2; ++nt)
#pragma unroll
            for (int i = 0; i < 16; ++i) {
                const int pos = crow(i, hh), ch = 32 * nt + r;
                const float rg = __builtin_amdgcn_rcpf(1.0f + __builtin_amdgcn_exp2f(ga[nt][i] + ba_[nt])), ig = __builtin_amdgcn_rcpf(1.0f + __builtin_amdgcn_exp2f(gx[nt][i] + bx_[nt]));
                const float a = __builtin_amdgcn_exp2f(c8_[nt] * rg);
                const float mult = __builtin_amdgcn_sqrtf(fmaxf(1.0f - a * a, 0.f));
                const float xc = xs[pos * LR_XS + ch];
                xs[pos * LR_XS + ch] = a;
                bs[pos * 64 + ch] = mult * ig * xc;
            }
        float gr[32];
        { const unsigned go = (unsigned)p0 * (PROJ_LD * 2) + lane * 2;
#pragma unroll
          for (int pp = 0; pp < 32; ++pp) gr[pp] = ldbf(gbase + (go + (unsigned)pp * (PROJ_LD * 2))); }
        if (tile + 1 < SEQ / 256) {
            const unsigned xo = (unsigned)(p0 + 256 - 3) * (PROJ_LD * 2) + lane * 2;
#pragma unroll
            for (int j = 0; j < 35; ++j) xr[j] = ldbf(xbase + (xo + (unsigned)j * (PROJ_LD * 2)));
        }
        {
            float hl = 0.f, cp = 1.f;
#pragma unroll 8
            for (int pp = 0; pp < 32; ++pp) {
                const float a = xs[pp * LR_XS + lane], bt = bs[pp * 64 + lane];
                hl = a * hl + bt; cp *= a;
                bs[pp * 64 + lane] = hl; xs[pp * LR_XS + lane] = cp;
            }
            cwl[((tile & 1) * 8 + w) * 64 + lane] = (f32x2){cp, hl};
        }
        WG_BAR();
        {
            float cin = carry, call = carry;
#pragma unroll
            for (int ww = 0; ww < 8; ++ww) { const f32x2 ab = cwl[((tile & 1) * 8 + ww) * 64 + lane]; call = ab[0] * call + ab[1]; if (ww + 1 == w) cin = call; }
            carry = call;
            const unsigned yo = (unsigned)p0 * (DM * 2) + lane * 2;
#pragma unroll
            for (int pp = 0; pp < 32; ++pp) {
                const float hv = bs[pp * 64 + lane] + xs[pp * LR_XS + lane] * cin;
                *(bf16_t*)(ybase + (yo + (unsigned)pp * (DM * 2))) = (bf16_t)(cvtpk(gr[pp] * hv, 0.f) & 0xffffu);
            }
        }
    }
    WG_BAR();
}

constexpr int SG_RS = 288, SG_IMG = 128 * SG_RS, SG_STAT = SG_IMG, SG_OUT = SG_IMG + 1024, SG_OS = 132;
typedef short v4i16_t __attribute__((ext_vector_type(4)));
__device__ __forceinline__ v4i16_t lds_tr16(const LAS unsigned char* p) { return __builtin_amdgcn_ds_read_tr16_b64_v4i16((LAS v4i16_t*)p); }
__device__ __forceinline__ void sgu_unit(const Params& P, int o, int unit, LAS unsigned char* lds) {
    int tid_ = threadIdx.x; asm volatile("" : "+v"(tid_));
    const int tid = tid_, lane = tid & 63, w = __builtin_amdgcn_readfirstlane(tid >> 6), r = lane & 31, hh = lane >> 5;
    const bf16_t* Z = (const bf16_t*)(P.ws + WS_H); bf16_t* Y = (bf16_t*)(P.ws + WS_Y);
    const int g = unit & 7; const size_t row0 = (size_t)(unit >> 3) * 128;
    const int c16 = tid & 15, qt = tid >> 4;
    LAS f32x2* stat = (LAS f32x2*)(lds + SG_STAT);
    if (tid < 128) {
        const f32x4* lp = (const f32x4*)((const float*)(P.ws + WS_LNS) + (row0 + tid) * 32);
        float sum = 0.f, sq = 0.f;
#pragma unroll
        for (int i = 0; i < 8; ++i) { const f32x4 t = lp[i]; sum += t[0] + t[2]; sq += t[1] + t[3]; }
        const float mean = sum * (1.0f / 1024.0f), var = sq * (1.0f / 1024.0f) - mean * mean;
        stat[tid] = (f32x2){mean, rsqrtf(var + RMS_EPS)};
    }
    u32x4 zraw[4], uraw[4];
#pragma unroll
    for (int i = 0; i < 4; ++i) { const bf16_t* zp = Z + (row0 + qt + 32 * i) * PROJ_LD + g * 128 + c16 * 8; zraw[i] = *(const u32x4*)(zp + 1024); uraw[i] = *(const u32x4*)zp; }
    float lg[8], lb[8];
    { const float* gp = P.in[19] + o * 1024 + g * 128 + c16 * 8; const float* bp = P.in[20] + o * 1024 + g * 128 + c16 * 8;
      const f32x4 g0 = *(const f32x4*)gp, g1 = *(const f32x4*)(gp + 4), b0 = *(const f32x4*)bp, b1 = *(const f32x4*)(bp + 4);
#pragma unroll
      for (int e2 = 0; e2 < 4; ++e2) { lg[e2] = g0[e2]; lg[4 + e2] = g1[e2]; lb[e2] = b0[e2]; lb[4 + e2] = b1[e2]; } }
    WG_BAR();
#pragma unroll
    for (int i = 0; i < 4; ++i) {
        const int q = qt + 32 * i; const f32x2 st = stat[q]; const u32x4 raw = zraw[i];
        float v[8];
        v[0] = __uint_as_float(raw.x << 16); v[1] = __uint_as_float(raw.x & 0xffff0000u); v[2] = __uint_as_float(raw.y << 16); v[3] = __uint_as_float(raw.y & 0xffff0000u);
        v[4] = __uint_as_float(raw.z << 16); v[5] = __uint_as_float(raw.z & 0xffff0000u); v[6] = __uint_as_float(raw.w << 16); v[7] = __uint_as_float(raw.w & 0xffff0000u);
#pragma unroll
        for (int e2 = 0; e2 < 8; ++e2) v[e2] = (v[e2] - st[0]) * st[1] * lg[e2] + lb[e2];
        u32x4 pk; pk.x = cvtpk(v[0], v[1]); pk.y = cvtpk(v[2], v[3]); pk.z = cvtpk(v[4], v[5]); pk.w = cvtpk(v[6], v[7]);
        *(LAS u32x4*)(lds + q * SG_RS + c16 * 16) = pk;
    }
    WG_BAR();
    const int pb = w >> 1, cb0 = (w & 1) * 2;
    f32x16 acc[2];
#pragma unroll
    for (int cc = 0; cc < 2; ++cc)
#pragma unroll
        for (int i = 0; i < 16; ++i) acc[cc][i] = 0.f;
    const bf16_t* wsm = (const bf16_t*)(P.ws + WS_SMALL + SM_WS) + ((size_t)(o * 8 + g) * 128 + 32 * pb + r) * 128 + 8 * hh;
    const int trb = (8 * hh + ((lane & 15) >> 2)) * SG_RS + (16 * ((lane >> 4) & 1) + 4 * (lane & 3)) * 2;
#pragma unroll
    for (int ks = 0; ks < 8; ++ks) {
        if (pb >= 2 || ks < 4) {
            const bf16x8 af = *(const bf16x8*)(wsm + 16 * ks);
#pragma unroll
            for (int cc = 0; cc < 2; ++cc) {
                const LAS unsigned char* tp = lds + trb + 16 * ks * SG_RS + 32 * (cb0 + cc) * 2;
                const v4i16_t lo = lds_tr16(tp), hi = lds_tr16(tp + 4 * SG_RS);
                const bf16x8 bfr = (bf16x8){lo[0], lo[1], lo[2], lo[3], hi[0], hi[1], hi[2], hi[3]};
                acc[cc] = MFMA32(af, bfr, acc[cc]);
            }
        }
    }
    const float* bsp = P.in[22] + (o * 8 + g) * 128 + 32 * pb;
    LAS float* oimg = (LAS float*)(lds + SG_OUT);
#pragma unroll
    for (int cc = 0; cc < 2; ++cc)
#pragma unroll
        for (int i = 0; i < 16; ++i) { const int pl = crow(i, hh); oimg[(32 * pb + pl) * SG_OS + 32 * (cb0 + cc) + r] = acc[cc][i] + bsp[pl]; }
    WG_BAR();
#pragma unroll
    for (int i = 0; i < 4; ++i) {
        const int p = qt + 32 * i; const u32x4 raw = uraw[i];
        const f32x4 m0 = *(const LAS f32x4*)(oimg + p * SG_OS + c16 * 8), m1 = *(const LAS f32x4*)(oimg + p * SG_OS + c16 * 8 + 4);
        u32x4 pk;
        pk.x = cvtpk(__uint_as_float(raw.x << 16) * m0[0], __uint_as_float(raw.x & 0xffff0000u) * m0[1]); pk.y = cvtpk(__uint_as_float(raw.y << 16) * m0[2], __uint_as_float(raw.y & 0xffff0000u) * m0[3]);
        pk.z = cvtpk(__uint_as_float(raw.z << 16) * m1[0], __uint_as_float(raw.z & 0xffff0000u) * m1[1]); pk.w = cvtpk(__uint_as_float(raw.w << 16) * m1[2], __uint_as_float(raw.w & 0xffff0000u) * m1[3]);
        *(u32x4*)(Y + (row0 + p) * DM + g * 128 + c16 * 8) = pk;
    }
}

__device__ __forceinline__ void final_norm_phase(const Params& P) {
    int tid_ = threadIdx.x; asm volatile("" : "+v"(tid_));
    const int tid = tid_, lane = tid & 63, wave = tid >> 6;
    const int gw = blockIdx.x * 8 + wave, NGW = gridDim.x * 8;
    const bf16_t* xb = (const bf16_t*)(P.ws + WS_XB);
    const f32x4* gp = (const f32x4*)P.in[3] + lane;
    f32x4 gv[4];
#pragma unroll
    for (int j = 0; j < 4; ++j) gv[j] = gp[64 * j];
    for (int m = gw; m < MTOK; m += 2 * NGW) {
        const int m1 = (m + NGW < MTOK) ? m + NGW : m;
        const u32x2* xr0 = (const u32x2*)(xb + (size_t)m * DM) + lane;
        const u32x2* xr1 = (const u32x2*)(xb + (size_t)m1 * DM) + lane;
        u32x2 t0[4], t1[4];
#pragma unroll
        for (int j = 0; j < 4; ++j) { t0[j] = xr0[64 * j]; t1[j] = xr1[64 * j]; }
        f32x4 v0[4], v1[4]; float s0 = 0.f, s1 = 0.f;
#pragma unroll
        for (int j = 0; j < 4; ++j) {
            v0[j][0] = __uint_as_float(t0[j].x << 16); v0[j][1] = __uint_as_float(t0[j].x & 0xffff0000u); v0[j][2] = __uint_as_float(t0[j].y << 16); v0[j][3] = __uint_as_float(t0[j].y & 0xffff0000u);
            v1[j][0] = __uint_as_float(t1[j].x << 16); v1[j][1] = __uint_as_float(t1[j].x & 0xffff0000u); v1[j][2] = __uint_as_float(t1[j].y << 16); v1[j][3] = __uint_as_float(t1[j].y & 0xffff0000u);
            s0 += (v0[j][0] * v0[j][0] + v0[j][1] * v0[j][1]) + (v0[j][2] * v0[j][2] + v0[j][3] * v0[j][3]);
            s1 += (v1[j][0] * v1[j][0] + v1[j][1] * v1[j][1]) + (v1[j][2] * v1[j][2] + v1[j][3] * v1[j][3]); }
        const float rs0 = rsqrtf(wave_sum(s0) * (1.0f / 1024.0f) + RMS_EPS), rs1 = rsqrtf(wave_sum(s1) * (1.0f / 1024.0f) + RMS_EPS);
        f32x4* o0 = (f32x4*)(P.out + (size_t)m * DM) + lane;
#pragma unroll
        for (int j = 0; j < 4; ++j) o0[64 * j] = v0[j] * rs0 * gv[j];
        if (m1 != m) {
            f32x4* o1 = (f32x4*)(P.out + (size_t)m1 * DM) + lane;
#pragma unroll
            for (int j = 0; j < 4; ++j) o1[64 * j] = v1[j] * rs1 * gv[j];
        }
    }
}

constexpr int LDS_RSL = 131072;
template <bool COLS> __device__ __forceinline__ void fill_rs(LAS float* rsl, const pg8::StaticOrder& S, const float* part) {
    int tid_ = threadIdx.x; asm volatile("" : "+v"(tid_));
    LAS int* ul = (LAS int*)(rsl + 14 * 256);
    if (tid_ < 16) { pg8::Unit u; int v = -1; if (tid_ < 14 && S.next(tid_, u)) v = COLS ? u.pn : u.pm; ul[tid_] = v; }
    __syncthreads();
    for (int idx = tid_; idx < 14 * 256; idx += 512) {
        const int p = ul[idx >> 8]; if (p < 0) break;
        rsl[idx] = pg8::rs_from_part(part, p * 256 + (idx & 255));
    }
    __syncthreads();
}

__global__ void __launch_bounds__(512, 2) fwd_kernel(Params P) {
    extern __shared__ __attribute__((aligned(16))) unsigned char lds_raw[];
    LAS unsigned char* lds = (LAS unsigned char*)lds_raw;
    cg::grid_group grid = cg::this_grid();
    unsigned char* ws = P.ws;
    const int G = gridDim.x, bx = blockIdx.x;
    bf16_t* XB = (bf16_t*)(ws + WS_XB); bf16_t* YB = (bf16_t*)(ws + WS_Y); bf16_t* HB = (bf16_t*)(ws + WS_H); bf16_t* VT = (bf16_t*)(ws + WS_VT);
    float* part = (float*)(ws + WS_PART); pg8::f32x2v* lns = (pg8::f32x2v*)(ws + WS_LNS);

    LAS unsigned* misc = (LAS unsigned*)(lds + LDS_CTL);
    if (threadIdx.x < 16) misc[threadIdx.x] = 0u;
    __syncthreads();
    prologue_phase(P, lds);
    grid.sync();
    const XcdBarrier xbar = xcd_barrier_post((unsigned*)(ws + WS_CTL) + CW_BAR, (volatile LAS unsigned*)(misc + 8));
#define GSYNC() xcd_barrier(xbar)

    for (int l = 0; l < 4; ++l) {
        const int e = l >> 1;
        if ((l & 1) == 0) {
            { const bf16_t* Wt = (const bf16_t*)(ws + WS_WIN) + (size_t)e * 2560 * 1024;
              { pg8::Gemm g{XB, Wt, MTOK, 2048, 1024}; pg8::StaticOrder S; S.init(MTOK, 2048, G, bx);
                fill_rs<false>((LAS float*)(lds + LDS_RSL), S, part);
                pg8::EpiScaleAct<0, false, 6> E{HB, PROJ_LD, (const LAS float*)(lds + LDS_RSL), lns};
                pg8::gemm_phase<pg8::EpiScaleAct<0, false, 6>, pg8::StaticOrder, true, true>(lds, g, S, E); }
              { pg8::Gemm g{Wt + (size_t)2048 * 1024, XB, 512, MTOK, 1024}; pg8::StaticOrder S; S.init(512, MTOK, G, bx);
                fill_rs<true>((LAS float*)(lds + LDS_RSL), S, part);
                pg8::EpiVT E{VT, MTOK, (const LAS float*)(lds + LDS_RSL)};
                pg8::gemm_phase<pg8::EpiVT, pg8::StaticOrder, true, true>(lds, g, S, E); } }
            GSYNC();
            if (l == 0 && threadIdx.x == 0) {
                unsigned ok = (((unsigned)G & 7u) == 0u) ? 1u : 0u;
                for (unsigned j = 0; j < 8u; ++j) { const unsigned a = xb_ld(xbar.bar + XB_GRP(j)), c = xb_ld(xbar.bar + XB_GRP(j) + 16); if (a == 0u || a > 8u || a + c != 9u) ok = 0u; }
                misc[12] = ok;
            }
            { const float lam = ((const float*)(ws + WS_SMALL + SM_LAM))[e];
              const float lam_init = (e == 0) ? 0.2f : (0.8f - 0.6f * 0.54881163609f);
              LAS unsigned* bc = (LAS unsigned*)(lds + LDS_CTL);
              unsigned* qbase = (unsigned*)(ws + WS_CTL) + e * 8;
              for (int kq = 0; kq < 8; ++kq) {
                  const int xq = (bx + kq) & 7;
                  if (kq == 1) {
                      int t_ = threadIdx.x; asm volatile("" : "+v"(t_));
                      if (t_ >= 1 && t_ < 8) bc[t_] = __hip_atomic_load(qbase + ((bx + t_) & 7), __ATOMIC_RELAXED, __HIP_MEMORY_SCOPE_AGENT);
                      WG_BAR();
                  }
                  if (kq >= 1 && bc[kq] >= (unsigned)(8 + 128)) continue;
                  if (threadIdx.x == 0) bc[0] = atomicAdd(qbase + xq, 1u);
                  for (;;) {
                      WG_BAR();
                      const unsigned idx = bc[0];
                      WG_BAR();
                      if (idx >= (unsigned)(8 + 128)) break;
                      unsigned pre = 0u;
                      if (idx < 8u) { lru_unit(P, e, xq, (int)idx, lds); if (threadIdx.x == 0) pre = atomicAdd(qbase + xq, 1u); }
                      else { const int a = (int)idx - 8; const int qb = 31 - (a >> 2), h = a & 3;
                             attn_unit(HB, VT, YB, P.in[9] + e * 128, lam, 1.0f - lam_init, xq, h, qb, qbase + xq, pre, lds); }
                      if (threadIdx.x == 0) bc[0] = pre;
                  }
              } }
            GSYNC();
        } else {
            { const bf16_t* Wt = (const bf16_t*)(ws + WS_CIN) + (size_t)e * 2048 * 1024;
              pg8::Gemm g{XB, Wt, MTOK, 2048, 1024}; pg8::StaticOrder S; S.init(MTOK, 2048, G, bx);
              fill_rs<false>((LAS float*)(lds + LDS_RSL), S, part);
              pg8::EpiScaleAct<1, true> E{HB, PROJ_LD, (const LAS float*)(lds + LDS_RSL), lns};
              pg8::gemm_phase<pg8::EpiScaleAct<1, true>, pg8::StaticOrder, true, true>(lds, g, S, E); }
            GSYNC();
            for (int u = bx; u < 2048; u += G) sgu_unit(P, e, u, lds);
            GSYNC();
        }
        { const bf16_t* Wt = (l & 1) ? (const bf16_t*)(ws + WS_COUT) + (size_t)e * 1024 * 1024 : (const bf16_t*)(ws + WS_WOUT) + (size_t)e * 1024 * 1024;
          pg8::Gemm g{YB, Wt, MTOK, 1024, 1024}; pg8::StaticOrder S; S.init(MTOK, 1024, G, bx);
          pg8::EpiResid E{XB, part};
          pg8::gemm_phase<pg8::EpiResid, pg8::StaticOrder, true, true>(lds, g, S, E); }
        xcd_barrier(xbar, *(volatile LAS unsigned*)(misc + 12) != 0u);
        { const bf16_t* Wt = (const bf16_t*)(ws + WS_W1) + (size_t)l * 4096 * 1024;
          pg8::Gemm g{XB, Wt, MTOK, 4096, 1024}; pg8::StaticOrder S; S.init(MTOK, 4096, G, bx);
          fill_rs<false>((LAS float*)(lds + LDS_RSL), S, part);
          pg8::EpiScaleAct<2, false> E{HB, DFF, (const LAS float*)(lds + LDS_RSL), lns};
          pg8::gemm_phase<pg8::EpiScaleAct<2, false>, pg8::StaticOrder, true, true>(lds, g, S, E); }
        xcd_barrier(xbar, *(volatile LAS unsigned*)(misc + 12) != 0u);
        { const bf16_t* Wt = (const bf16_t*)(ws + WS_W2) + (size_t)l * 1024 * 4096;
          pg8::Gemm g{HB, Wt, MTOK, 1024, 4096}; pg8::StaticOrder S; S.init(MTOK, 1024, G, bx);
          pg8::EpiResid E{XB, part};
          pg8::gemm_phase<pg8::EpiResid, pg8::StaticOrder, true, true>(lds, g, S, E); }
        GSYNC();
    }
    final_norm_phase(P);
}

extern "C" void kernel_launch(void* const* d_in, const int* in_sizes, int n_in, void* d_out, int out_size, void* d_ws, size_t ws_size, hipStream_t stream) {
    static int grid = 0;
    if (grid == 0) {
        if (n_in != 26 || in_sizes[0] != MTOK * DM || out_size != MTOK * DM || ws_size < WS_END) {
            fprintf(stderr, "kernel_launch: unexpected shapes (n_in %d, in0 %d, out %d, ws %zu; need ws >= %zu); nothing launched\n", n_in, n_in > 0 ? in_sizes[0] : -1, out_size, ws_size, (size_t)WS_END);
            grid = -1; return; }
        int dev = 0, cus = 0, per_cu = 0;
        if (hipGetDevice(&dev) != hipSuccess || hipDeviceGetAttribute(&cus, hipDeviceAttributeMultiprocessorCount, dev) != hipSuccess) { fprintf(stderr, "kernel_launch: device query failed\n"); grid = -1; return; }
        if (hipFuncSetAttribute((const void*)fwd_kernel, hipFuncAttributeMaxDynamicSharedMemorySize, LDS_BYTES) != hipSuccess) { fprintf(stderr, "kernel_launch: hipFuncSetAttribute failed\n"); grid = -1; return; }
        if (hipOccupancyMaxActiveBlocksPerMultiprocessor(&per_cu, (const void*)fwd_kernel, 512, LDS_BYTES) != hipSuccess || per_cu < 1) { fprintf(stderr, "kernel_launch: occupancy query gave %d\n", per_cu); per_cu = 1; }
        (void)hipGetLastError();
        grid = cus * per_cu;
    }
    if (grid < 0) return;
    Params p{};
    for (int i = 0; i < 26; ++i) p.in[i] = (const float*)d_in[i];
    p.out = (float*)d_out; p.ws = (unsigned char*)d_ws;
    void* args[] = {&p};
    hipError_t err = hipLaunchCooperativeKernel((const void*)fwd_kernel, dim3(grid), dim3(512), args, LDS_BYTES, stream);
    if (err != hipSuccess) fprintf(stderr, "kernel_launch: cooperative launch failed: %s (grid %d)\n", hipGetErrorString(err), grid);
}
```
